# Optimizing an MI355X kernel written in HIP

```python
import jax, jax.numpy as jnp
from jax import lax
import numpy as np

D_MODEL = 1024
BATCH = 2
SEQ = 8192
DEPTH = 4

CHUNK = 64
QBLOCK = 128
PLE_DIM = 256
EPS = 1e-6
NEG_INF = -1e30
MLA_HEADS = 8
MLA_NOPE = 64
MLA_ROPE = 32
MLA_V = 64
MLA_Q_LORA = 384
MLA_KV_LORA = 256
ROPE_THETA = 10000.0
CHK_HEADS = 8
CHK_DIM = 64
LEFT_CHUNKS = 8
REL_CLIP = 256
FOX_HEADS = 16
FOX_DIM = 64
MLA_WIDTH = MLA_HEADS * MLA_V
CHK_WIDTH = CHK_HEADS * CHK_DIM
FOX_WIDTH = FOX_HEADS * FOX_DIM
AB_SIZES = (MLA_Q_LORA, MLA_KV_LORA, MLA_ROPE, MLA_WIDTH, CHK_WIDTH, CHK_WIDTH, CHK_WIDTH, CHK_WIDTH)
AB_IN = sum(AB_SIZES)
FOX_SIZES = (FOX_WIDTH, FOX_WIDTH, FOX_WIDTH, FOX_WIDTH, FOX_HEADS)
FOX_IN = sum(FOX_SIZES)
N_AB = (DEPTH + 1) // 2
N_FOX = DEPTH // 2

kernel_name = 'hybrid_mla_chunkrel_fox_trunk'


def rms_norm(x, g):
    xf = x.astype(jnp.float32)
    y = xf * lax.rsqrt(jnp.mean(xf * xf, axis=-1, keepdims=True) + EPS)
    return (y * g.astype(jnp.float32)).astype(x.dtype)


def split_cols(z, sizes):
    return jnp.split(z, np.cumsum(sizes)[:-1].tolist(), axis=-1)


def apply_rope(x, positions):
    half = x.shape[-1] // 2
    inv_freq = 1.0 / (ROPE_THETA ** (jnp.arange(half, dtype=jnp.float32) / half))
    ang = positions.astype(jnp.float32)[:, :, None, None] * inv_freq
    cos, sin = jnp.cos(ang), jnp.sin(ang)
    xf = x.astype(jnp.float32)
    x1, x2 = xf[..., :half], xf[..., half:]
    return jnp.concatenate([x1 * cos - x2 * sin, x2 * cos + x1 * sin], axis=-1).astype(x.dtype)


def blocked_attention(q, k, v, scale, logit_fn):
    B, S, H, Dk = q.shape
    nb = S // QBLOCK
    qb = q.reshape(B, nb, QBLOCK, H, Dk).transpose(1, 0, 2, 3, 4)

    def one_block(args):
        q_i, b_i = args
        s = jnp.einsum('bqhd,bkhd->bhqk', q_i, k, preferred_element_type=jnp.float32) * scale
        s = logit_fn(s, b_i)
        pr = jax.nn.softmax(s, axis=-1).astype(v.dtype)
        return jnp.einsum('bhqk,bkhd->bqhd', pr, v)

    out = lax.map(one_block, (qb, jnp.arange(nb)))
    return out.transpose(1, 0, 2, 3, 4).reshape(B, S, H, v.shape[-1])


def mla_attention(cq, ckv, kr, positions, q_norm, w_uq, kv_norm, w_ukv, q_gain, k_gain):
    B, S, _ = cq.shape
    q = (rms_norm(cq, q_norm) @ w_uq).reshape(B, S, MLA_HEADS, MLA_NOPE + MLA_ROPE)
    kv = (rms_norm(ckv, kv_norm) @ w_ukv).reshape(B, S, MLA_HEADS, MLA_NOPE + MLA_V)
    k_nope, v = kv[..., :MLA_NOPE], kv[..., MLA_NOPE:]
    k_rope = jnp.broadcast_to(kr[:, :, None, :], (B, S, MLA_HEADS, MLA_ROPE))
    k = jnp.concatenate([k_nope, k_rope], axis=-1)
    q = rms_norm(q, q_gain)
    k = rms_norm(k, k_gain)
    q = jnp.concatenate([q[..., :MLA_NOPE], apply_rope(q[..., MLA_NOPE:], positions)], axis=-1)
    k = jnp.concatenate([k[..., :MLA_NOPE], apply_rope(k[..., MLA_NOPE:], positions)], axis=-1)
    key_chunk = jnp.arange(S) // CHUNK

    def chunk_causal(s, b_i):
        q_chunk = (b_i * QBLOCK + jnp.arange(QBLOCK)) // CHUNK
        mask = key_chunk[None, :] <= q_chunk[:, None]
        return jnp.where(mask[None, None], s, NEG_INF)

    o = blocked_attention(q, k, v, (MLA_NOPE + MLA_ROPE) ** -0.5, chunk_causal)
    return o.reshape(B, S, MLA_WIDTH)


def chunk_rel_attention(q, k, v, rel_bias):
    B, S, H, Dh = q.shape
    nC = S // CHUNK
    band = (LEFT_CHUNKS + 1) * CHUNK
    qc = q.reshape(B, nC, CHUNK, H, Dh)
    pad = ((0, 0), (LEFT_CHUNKS, 0), (0, 0), (0, 0), (0, 0))
    kp = jnp.pad(k.reshape(B, nC, CHUNK, H, Dh), pad)
    vp = jnp.pad(v.reshape(B, nC, CHUNK, H, Dh), pad)
    cidx = jnp.arange(nC)[:, None] + jnp.arange(LEFT_CHUNKS + 1)[None, :]
    kb = kp[:, cidx].reshape(B, nC, band, H, Dh)
    vb = vp[:, cidx].reshape(B, nC, band, H, Dh)
    s = jnp.einsum('bcqhd,bckhd->bhcqk', qc, kb, preferred_element_type=jnp.float32) * (Dh ** -0.5)
    dist = LEFT_CHUNKS * CHUNK + jnp.arange(CHUNK)[:, None] - jnp.arange(band)[None, :]
    ridx = jnp.clip(dist, -REL_CLIP, REL_CLIP) + REL_CLIP
    bias = rel_bias.astype(jnp.float32)[:, ridx]
    valid = jnp.repeat(cidx >= LEFT_CHUNKS, CHUNK, axis=1)
    s = jnp.where(valid[None, None, :, None, :], s + bias[None, :, None], NEG_INF)
    pr = jax.nn.softmax(s, axis=-1).astype(v.dtype)
    o = jnp.einsum('bhcqk,bckhd->bcqhd', pr, vb)
    return o.reshape(B, S, H * Dh)


def forgetting_attention(q, k, v, f_logit, b_f):
    B, S, H, Dh = q.shape
    log_f = jax.nn.log_sigmoid(f_logit.astype(jnp.float32) + b_f.astype(jnp.float32))
    cum = lax.cumsum(log_f, axis=1).transpose(0, 2, 1)
    kpos = jnp.arange(S)

    def decay_causal(s, b_i):
        cq = lax.dynamic_slice_in_dim(cum, b_i * QBLOCK, QBLOCK, axis=2)
        qpos = b_i * QBLOCK + jnp.arange(QBLOCK)
        mask = kpos[None, :] <= qpos[:, None]
        return jnp.where(mask[None, None], s + cq[..., :, None] - cum[..., None, :], NEG_INF)

    o = blocked_attention(q, k, v, Dh ** -0.5, decay_causal)
    return o.reshape(B, S, H * Dh)


def setup_inputs(seed: int = 0) -> dict:
    key = jax.random.key(seed)
    ks = jax.random.split(key, 24)

    def nrm(k, shape, scale):
        return jax.random.normal(k, shape, jnp.float32) * scale

    def gain(k, shape):
        return 1.0 + nrm(k, shape, 0.05)

    offsets = jax.random.randint(ks[2], (BATCH, 1), 0, 4096, dtype=jnp.int32)
    positions = offsets + jnp.arange(SEQ, dtype=jnp.int32)[None, :]
    return {
        'x': nrm(ks[0], (BATCH, SEQ, D_MODEL), 1.0),
        'p': nrm(ks[1], (DEPTH, BATCH, SEQ, PLE_DIM), 1.0),
        'positions': positions,
        'norm_g': gain(ks[3], (DEPTH, D_MODEL)),
        'ab_w_in': nrm(ks[4], (N_AB, D_MODEL, AB_IN), D_MODEL ** -0.5),
        'mla_q_norm': gain(ks[5], (N_AB, MLA_Q_LORA)),
        'mla_w_uq': nrm(ks[6], (N_AB, MLA_Q_LORA, MLA_HEADS * (MLA_NOPE + MLA_ROPE)), MLA_Q_LORA ** -0.5),
        'mla_kv_norm': gain(ks[7], (N_AB, MLA_KV_LORA)),
        'mla_w_ukv': nrm(ks[8], (N_AB, MLA_KV_LORA, MLA_HEADS * (MLA_NOPE + MLA_V)), MLA_KV_LORA ** -0.5),
        'mla_q_gain': gain(ks[9], (N_AB, MLA_NOPE + MLA_ROPE)),
        'mla_k_gain': gain(ks[10], (N_AB, MLA_NOPE + MLA_ROPE)),
        'chk_q_gain': gain(ks[11], (N_AB, CHK_DIM)),
        'chk_k_gain': gain(ks[12], (N_AB, CHK_DIM)),
        'chk_rel_bias': nrm(ks[13], (N_AB, CHK_HEADS, 2 * REL_CLIP + 1), 0.1),
        'ab_w_out': nrm(ks[14], (N_AB, MLA_WIDTH + CHK_WIDTH, D_MODEL), (MLA_WIDTH + CHK_WIDTH) ** -0.5),
        'fox_w_in': nrm(ks[15], (N_FOX, D_MODEL, FOX_IN), D_MODEL ** -0.5),
        'fox_b_f': 2.0 + nrm(ks[16], (N_FOX, FOX_HEADS), 0.1),
        'fox_q_gain': gain(ks[17], (N_FOX, FOX_DIM)),
        'fox_k_gain': gain(ks[18], (N_FOX, FOX_DIM)),
        'fox_w_out': nrm(ks[19], (N_FOX, FOX_WIDTH, D_MODEL), FOX_WIDTH ** -0.5),
        'pe_w': nrm(ks[20], (DEPTH, PLE_DIM, D_MODEL), PLE_DIM ** -0.5),
        'pe_gate_norm': gain(ks[21], (DEPTH, D_MODEL)),
        'pe_gate_w': nrm(ks[22], (DEPTH, D_MODEL, D_MODEL), D_MODEL ** -0.5),
    }


def reference(x, p, positions, norm_g, ab_w_in, mla_q_norm, mla_w_uq, mla_kv_norm, mla_w_ukv,
              mla_q_gain, mla_k_gain, chk_q_gain, chk_k_gain, chk_rel_bias, ab_w_out,
              fox_w_in, fox_b_f, fox_q_gain, fox_k_gain, fox_w_out, pe_w, pe_gate_norm, pe_gate_w):
    B, S, _ = x.shape
    h = x
    for i in range(DEPTH):
        u = rms_norm(h, norm_g[i])
        l = i // 2
        if i % 2 == 0:
            cq, ckv, kr, g_a, q_b, k_b, v_b, g_b = split_cols(u @ ab_w_in[l], AB_SIZES)
            o_a = mla_attention(cq, ckv, kr, positions, mla_q_norm[l], mla_w_uq[l],
                                mla_kv_norm[l], mla_w_ukv[l], mla_q_gain[l], mla_k_gain[l])
            q_b = rms_norm(q_b.reshape(B, S, CHK_HEADS, CHK_DIM), chk_q_gain[l])
            k_b = rms_norm(k_b.reshape(B, S, CHK_HEADS, CHK_DIM), chk_k_gain[l])
            v_b = v_b.reshape(B, S, CHK_HEADS, CHK_DIM)
            o_b = chunk_rel_attention(q_b, k_b, v_b, chk_rel_bias[l])
            mixed = jnp.concatenate([o_a * jax.nn.silu(g_a), o_b * jax.nn.silu(g_b)], axis=-1) @ ab_w_out[l]
        else:
            q_c, k_c, v_c, g_c, f_c = split_cols(u @ fox_w_in[l], FOX_SIZES)
            q_c = rms_norm(q_c.reshape(B, S, FOX_HEADS, FOX_DIM), fox_q_gain[l])
            k_c = rms_norm(k_c.reshape(B, S, FOX_HEADS, FOX_DIM), fox_k_gain[l])
            v_c = v_c.reshape(B, S, FOX_HEADS, FOX_DIM)
            o_c = forgetting_attention(q_c, k_c, v_c, f_c, fox_b_f[l])
            mixed = (o_c * jax.nn.silu(g_c)) @ fox_w_out[l]
        h = h + mixed
        ple_gate = jax.nn.sigmoid(rms_norm(h, pe_gate_norm[i]) @ pe_gate_w[i])
        h = h + (p[i] @ pe_w[i]) * ple_gate
    return h
```

```cpp
#include <hip/hip_runtime.h>
#include <hip/hip_cooperative_groups.h>
#include <cstdio>
#include <cstdint>
namespace cg = cooperative_groups;

#ifndef USE_COOP
#define USE_COOP 1
#endif

#define DEVI __device__ __forceinline__
#define FENCE() do { asm volatile("" ::: "memory"); __builtin_amdgcn_sched_barrier(0); } while (0)
typedef unsigned short bf16_t;
typedef short bf16x8 __attribute__((ext_vector_type(8)));
typedef float f32x16 __attribute__((ext_vector_type(16)));
typedef float f32x4 __attribute__((ext_vector_type(4)));
typedef unsigned u32x4 __attribute__((ext_vector_type(4)));

constexpr int S_ = 8192, T_ = 16384;
constexpr float EPS_ = 1e-6f, LOG2E_ = 1.4426950408889634f;
constexpr int ZE = 2720, ZO = 3072;
constexpr int LDT = 72;
constexpr int SMEM_BYTES = 2 * 128 * LDT * 2 * 2 + 512;
constexpr int NPH = 24;

struct Params {
  const float* x; const float* p; const int* pos;
  const float* norm_g; const float* ab_w_in; const float* mla_q_norm; const float* mla_w_uq; const float* mla_kv_norm; const float* mla_w_ukv;
  const float* mla_q_gain; const float* mla_k_gain; const float* chk_q_gain; const float* chk_k_gain; const float* chk_rel_bias; const float* ab_w_out;
  const float* fox_w_in; const float* fox_b_f; const float* fox_q_gain; const float* fox_k_gain; const float* fox_w_out;
  const float* pe_w; const float* pe_gate_norm; const float* pe_gate_w;
  float* out;
  bf16_t* wt_in; bf16_t* wt_uq; bf16_t* wt_ukv; bf16_t* wt_out; bf16_t* wt_pe; bf16_t* wt_gate;
  float* cosT; float* sinT;
  bf16_t* uy; bf16_t* pb; bf16_t* z;
  bf16_t* qm; bf16_t* km; bf16_t* vtm; bf16_t* vt;
  float* logf; float* cum;
  unsigned* bar;
};

DEVI int tid_() { int t = __builtin_amdgcn_workitem_id_x(); asm volatile("" : "+v"(t)); return t; }
DEVI unsigned cvt_pk_bf16(float lo, float hi) { unsigned r; asm("v_cvt_pk_bf16_f32 %0, %1, %2" : "=v"(r) : "v"(lo), "v"(hi)); return r; }
DEVI float bf2f(bf16_t v) { return __uint_as_float(((unsigned)v) << 16); }
DEVI bf16_t f2bf(float f) { return (bf16_t)(cvt_pk_bf16(f, 0.f) & 0xffffu); }
DEVI float sigmoidf_(float x) { return __builtin_amdgcn_rcpf(1.f + __expf(-x)); }
DEVI float siluf_(float x) { return x * sigmoidf_(x); }
template <int M> DEVI float shx(float v) {
  if constexpr (M < 32) return __int_as_float(__builtin_amdgcn_ds_swizzle(__float_as_int(v), (M << 10) | 0x1f));
  else return __int_as_float(__builtin_amdgcn_ds_bpermute(((tid_() & 63) ^ 32) << 2, __float_as_int(v)));
}
DEVI float hsum32(float v) { v += shx<1>(v); v += shx<2>(v); v += shx<4>(v); v += shx<8>(v); v += shx<16>(v); return v; }
DEVI float sq2(unsigned u) { const float lo = __uint_as_float(u << 16), hi = __uint_as_float(u & 0xffff0000u); return lo * lo + hi * hi; }
DEVI int vbid() { const int G = gridDim.x, b = blockIdx.x; return ((G & 7) == 0) ? (b & 7) * (G >> 3) + (b >> 3) : b; }


__shared__ uint4 g_xb;
struct TileIter { int c, tl, nloc, nx, lid, ntiles, nct, nrt; };
DEVI void decode_item(int t, int nct, int nrt, int& rt, int& ct) {
  const int ng = nct >> 3, gs = nrt * 8;
  if (t < ng * gs) { const int g = t / gs, rem = t - g * gs; rt = rem >> 3; ct = g * 8 + (rem & 7); }
  else { const int wl = nct - 8 * ng, t2 = t - ng * gs; rt = t2 / wl; ct = 8 * ng + t2 % wl; }
}
DEVI void tile_begin(TileIter& ti, int nct, int nrt = 128, int nitems = -1) {
  const uint4 cx = g_xb;
  ti.nct = nct; ti.nrt = nrt; ti.ntiles = nitems < 0 ? nrt * nct : nitems;
  if (cx.x == 0u) { ti.lid = blockIdx.x; ti.c = 0; ti.tl = blockIdx.x; ti.nloc = gridDim.x; ti.nx = 0; return; }
  ti.nloc = (int)cx.x; ti.nx = (int)cx.y; ti.lid = (int)cx.z; ti.c = (int)cx.w; ti.tl = ti.lid;
}
DEVI bool tile_next(TileIter& ti, int& rt, int& ct) {
  int t;
  if (ti.nx == 0) { t = ti.tl; ti.tl += ti.nloc; if (t >= ti.ntiles) return false; }
  else {
    for (;;) {
      if (ti.c * 64 >= ti.ntiles) return false;
      if (ti.tl < 64) { t = ti.c * 64 + ti.tl; ti.tl += ti.nloc; if (t < ti.ntiles) break; continue; }
      ti.c += ti.nx; ti.tl = ti.lid;
    }
  }
  decode_item(t, ti.nct, ti.nrt, rt, ct);
  return true;
}

template <int BN, bool ROWSS, bool DEEP = true>
DEVI void gemm_mainloop(const bf16_t* __restrict__ A, int lda, const bf16_t* __restrict__ Bt, int ldb, int K,
                        f32x16 (&acc)[BN / 32], unsigned char* smem, f32x4& ss) {
  constexpr int TN = BN / 32;
  bf16_t* As = (bf16_t*)smem;
  bf16_t* Bs = As + 2 * 128 * LDT;
  const int tid = tid_(), lane = tid & 63, w = tid >> 6;
  const int lr = tid >> 3, kc = tid & 7;
  const bf16_t* ap = A + (size_t)lr * lda + kc * 8;
  const bf16_t* bp = Bt + (size_t)lr * ldb + kc * 8;
  const size_t sa = (size_t)32 * lda, sb = (size_t)32 * ldb;
  uint4 pa0, pa1, pa2, pa3, pb0, pb1, pb2, pb3, qa0, qa1, qa2, qa3, qb0, qb1, qb2, qb3;
#define GL_(X, ko) do { X##a0 = *(const uint4*)(ap + (ko)); X##a1 = *(const uint4*)(ap + sa + (ko)); X##a2 = *(const uint4*)(ap + 2 * sa + (ko)); X##a3 = *(const uint4*)(ap + 3 * sa + (ko)); \
    X##b0 = *(const uint4*)(bp + (ko)); if (TN > 1) X##b1 = *(const uint4*)(bp + sb + (ko)); if (TN > 2) X##b2 = *(const uint4*)(bp + 2 * sb + (ko)); if (TN > 3) X##b3 = *(const uint4*)(bp + 3 * sb + (ko)); } while (0)
#define SSQ_(v) (sq2((v).x) + sq2((v).y) + sq2((v).z) + sq2((v).w))
#define ST_(X, buf) do { bf16_t* a_ = As + (buf) * 128 * LDT + wr_off; bf16_t* b_ = Bs + (buf) * 128 * LDT + wr_off; \
    *(uint4*)(a_) = X##a0; *(uint4*)(a_ + 32 * LDT) = X##a1; *(uint4*)(a_ + 64 * LDT) = X##a2; *(uint4*)(a_ + 96 * LDT) = X##a3; \
    *(uint4*)(b_) = X##b0; if (TN > 1) *(uint4*)(b_ + 32 * LDT) = X##b1; if (TN > 2) *(uint4*)(b_ + 64 * LDT) = X##b2; if (TN > 3) *(uint4*)(b_ + 96 * LDT) = X##b3; \
    if (ROWSS) { ss[0] += SSQ_(X##a0); ss[1] += SSQ_(X##a1); ss[2] += SSQ_(X##a2); ss[3] += SSQ_(X##a3); } } while (0)
#define LDF_(S, Ac, Bc, ks) do { S##a = *(const bf16x8*)((Ac) + 16 * (ks)); S##b0 = *(const bf16x8*)((Bc) + 16 * (ks)); if (TN > 1) S##b1 = *(const bf16x8*)((Bc) + 32 * LDT + 16 * (ks)); \
    if (TN > 2) S##b2 = *(const bf16x8*)((Bc) + 64 * LDT + 16 * (ks)); if (TN > 3) S##b3 = *(const bf16x8*)((Bc) + 96 * LDT + 16 * (ks)); } while (0)
#define MF_(S) do { __builtin_amdgcn_s_setprio(1); acc[0] = __builtin_amdgcn_mfma_f32_32x32x16_bf16(S##a, S##b0, acc[0], 0, 0, 0); if (TN > 1) acc[TN > 1 ? 1 : 0] = __builtin_amdgcn_mfma_f32_32x32x16_bf16(S##a, S##b1, acc[TN > 1 ? 1 : 0], 0, 0, 0); \
    if (TN > 2) acc[TN > 2 ? 2 : 0] = __builtin_amdgcn_mfma_f32_32x32x16_bf16(S##a, S##b2, acc[TN > 2 ? 2 : 0], 0, 0, 0); if (TN > 3) acc[TN - 1] = __builtin_amdgcn_mfma_f32_32x32x16_bf16(S##a, S##b3, acc[TN - 1], 0, 0, 0); __builtin_amdgcn_s_setprio(0); } while (0)
#define MMA_(buf) do { const bf16_t* Ac = As + (buf) * 128 * LDT + a_rd; const bf16_t* Bc = Bs + (buf) * 128 * LDT + b_rd; \
    LDF_(fx, Ac, Bc, 0); __builtin_amdgcn_sched_barrier(0); \
    LDF_(fy, Ac, Bc, 1); __builtin_amdgcn_sched_barrier(0); MF_(fx); __builtin_amdgcn_sched_barrier(0); \
    LDF_(fx, Ac, Bc, 2); __builtin_amdgcn_sched_barrier(0); MF_(fy); __builtin_amdgcn_sched_barrier(0); \
    LDF_(fy, Ac, Bc, 3); __builtin_amdgcn_sched_barrier(0); MF_(fx); __builtin_amdgcn_sched_barrier(0); \
    MF_(fy); __builtin_amdgcn_sched_barrier(0); } while (0)
  bf16x8 fxa, fxb0, fxb1, fxb2, fxb3, fya, fyb0, fyb1, fyb2, fyb3;
  pb3 = make_uint4(0, 0, 0, 0); qb3 = pb3; pb2 = pb3; qb2 = pb3; pb1 = pb3; qb1 = pb3;
  GL_(p, 0);
  const int nk = K >> 6;
  const int fr = lane & 31, fh = lane >> 5;
  const int a_rd = (32 * w + fr) * LDT + 8 * fh;
  const int b_rd = fr * LDT + 8 * fh;
  const int wr_off = lr * LDT + kc * 8;
  if (ROWSS) { ss[0] = 0.f; ss[1] = 0.f; ss[2] = 0.f; ss[3] = 0.f; }
  if constexpr (!DEEP) {
    ST_(p, 0);
    __syncthreads();
#pragma unroll 1
    for (int kt = 0; kt < nk; kt += 2) {
      GL_(p, (kt + 1) * 64);
      MMA_(0);
      ST_(p, 1);
      __syncthreads();
      if (kt + 2 < nk) GL_(p, (kt + 2) * 64);
      MMA_(1);
      if (kt + 2 < nk) ST_(p, 0);
      __syncthreads();
    }
    return;
  }
  GL_(q, 64);
  ST_(p, 0);
  __syncthreads();
#pragma unroll 1
  for (int kt = 0; kt < nk; kt += 2) {
    if (kt + 2 < nk) GL_(p, (kt + 2) * 64);
    MMA_(0);
    ST_(q, 1);
    __syncthreads();
    if (kt + 3 < nk) GL_(q, (kt + 3) * 64);
    MMA_(1);
    if (kt + 2 < nk) ST_(p, 0);
    __syncthreads();
  }
#undef GL_
#undef ST_
#undef MMA_
#undef LDF_
#undef MF_
}

template <bool ROWSS>
DEVI void gemm_mainloop_f32a(const float* __restrict__ A, int lda, const bf16_t* __restrict__ Bt, int ldb, int K,
                             f32x16 (&acc)[4], unsigned char* smem, f32x4& ss) {
  constexpr int TN = 4;
  bf16_t* As = (bf16_t*)smem;
  bf16_t* Bs = As + 2 * 128 * LDT;
  const int tid = tid_(), lane = tid & 63, w = tid >> 6;
  const int lr = tid >> 3, kc = tid & 7;
  const float* ap = A + (size_t)lr * lda + kc * 8;
  const bf16_t* bp = Bt + (size_t)lr * ldb + kc * 8;
  const size_t sa = (size_t)32 * lda, sb = (size_t)32 * ldb;
  f32x4 a0l, a0h, a1l, a1h, a2l, a2h, a3l, a3h; uint4 rb0, rb1, rb2, rb3;
#define GLF_(ko) do { a0l = *(const f32x4*)(ap + (ko)); a0h = *(const f32x4*)(ap + (ko) + 4); a1l = *(const f32x4*)(ap + sa + (ko)); a1h = *(const f32x4*)(ap + sa + (ko) + 4); \
    a2l = *(const f32x4*)(ap + 2 * sa + (ko)); a2h = *(const f32x4*)(ap + 2 * sa + (ko) + 4); a3l = *(const f32x4*)(ap + 3 * sa + (ko)); a3h = *(const f32x4*)(ap + 3 * sa + (ko) + 4); \
    rb0 = *(const uint4*)(bp + (ko)); rb1 = *(const uint4*)(bp + sb + (ko)); rb2 = *(const uint4*)(bp + 2 * sb + (ko)); rb3 = *(const uint4*)(bp + 3 * sb + (ko)); } while (0)
#define CVT8_(l, h) make_uint4(cvt_pk_bf16((l)[0], (l)[1]), cvt_pk_bf16((l)[2], (l)[3]), cvt_pk_bf16((h)[0], (h)[1]), cvt_pk_bf16((h)[2], (h)[3]))
#define SQ8_(l, h) ((l)[0] * (l)[0] + (l)[1] * (l)[1] + (l)[2] * (l)[2] + (l)[3] * (l)[3] + (h)[0] * (h)[0] + (h)[1] * (h)[1] + (h)[2] * (h)[2] + (h)[3] * (h)[3])
#define STF_(buf) do { bf16_t* a_ = As + (buf) * 128 * LDT + wr_off; bf16_t* b_ = Bs + (buf) * 128 * LDT + wr_off; \
    *(uint4*)(a_) = CVT8_(a0l, a0h); *(uint4*)(a_ + 32 * LDT) = CVT8_(a1l, a1h); *(uint4*)(a_ + 64 * LDT) = CVT8_(a2l, a2h); *(uint4*)(a_ + 96 * LDT) = CVT8_(a3l, a3h); \
    *(uint4*)(b_) = rb0; *(uint4*)(b_ + 32 * LDT) = rb1; *(uint4*)(b_ + 64 * LDT) = rb2; *(uint4*)(b_ + 96 * LDT) = rb3; \
    if (ROWSS) { ss[0] += SQ8_(a0l, a0h); ss[1] += SQ8_(a1l, a1h); ss[2] += SQ8_(a2l, a2h); ss[3] += SQ8_(a3l, a3h); } } while (0)
#define LDF_(S, Ac, Bc, ks) do { S##a = *(const bf16x8*)((Ac) + 16 * (ks)); S##b0 = *(const bf16x8*)((Bc) + 16 * (ks)); S##b1 = *(const bf16x8*)((Bc) + 32 * LDT + 16 * (ks)); \
    S##b2 = *(const bf16x8*)((Bc) + 64 * LDT + 16 * (ks)); S##b3 = *(const bf16x8*)((Bc) + 96 * LDT + 16 * (ks)); } while (0)
#define MF_(S) do { acc[0] = __builtin_amdgcn_mfma_f32_32x32x16_bf16(S##a, S##b0, acc[0], 0, 0, 0); acc[1] = __builtin_amdgcn_mfma_f32_32x32x16_bf16(S##a, S##b1, acc[1], 0, 0, 0); \
    acc[2] = __builtin_amdgcn_mfma_f32_32x32x16_bf16(S##a, S##b2, acc[2], 0, 0, 0); acc[3] = __builtin_amdgcn_mfma_f32_32x32x16_bf16(S##a, S##b3, acc[3], 0, 0, 0); } while (0)
#define MMA_(buf) do { const bf16_t* Ac = As + (buf) * 128 * LDT + a_rd; const bf16_t* Bc = Bs + (buf) * 128 * LDT + b_rd; \
    LDF_(fx, Ac, Bc, 0); __builtin_amdgcn_sched_barrier(0); \
    LDF_(fy, Ac, Bc, 1); __builtin_amdgcn_sched_barrier(0); MF_(fx); __builtin_amdgcn_sched_barrier(0); \
    LDF_(fx, Ac, Bc, 2); __builtin_amdgcn_sched_barrier(0); MF_(fy); __builtin_amdgcn_sched_barrier(0); \
    LDF_(fy, Ac, Bc, 3); __builtin_amdgcn_sched_barrier(0); MF_(fx); __builtin_amdgcn_sched_barrier(0); \
    MF_(fy); __builtin_amdgcn_sched_barrier(0); } while (0)
  bf16x8 fxa, fxb0, fxb1, fxb2, fxb3, fya, fyb0, fyb1, fyb2, fyb3;
  GLF_(0);
  const int nk = K >> 6;
  const int fr = lane & 31, fh = lane >> 5;
  const int a_rd = (32 * w + fr) * LDT + 8 * fh;
  const int b_rd = fr * LDT + 8 * fh;
  const int wr_off = lr * LDT + kc * 8;
  if (ROWSS) { ss[0] = 0.f; ss[1] = 0.f; ss[2] = 0.f; ss[3] = 0.f; }
  STF_(0);
  __syncthreads();
#pragma unroll 1
  for (int kt = 0; kt < nk; kt += 2) {
    GLF_((kt + 1) * 64);
    MMA_(0);
    STF_(1);
    __syncthreads();
    if (kt + 2 < nk) GLF_((kt + 2) * 64);
    MMA_(1);
    if (kt + 2 < nk) STF_(0);
    __syncthreads();
  }
#undef GLF_
#undef STF_
#undef MMA_
#undef LDF_
#undef MF_
}

constexpr int LD2 = 40;
DEVI void gemm_mainloop2(const bf16_t* __restrict__ A0, const bf16_t* __restrict__ A1, int lda, const bf16_t* __restrict__ Bt, int ldb, int K,
                         f32x16 (&acc0)[4], f32x16 (&acc1)[4], unsigned char* smem) {
  bf16_t* L = (bf16_t*)smem;
  constexpr int STG = 384 * LD2;
  const int tid = tid_(), lane = tid & 63, w = tid >> 6;
  const int lr = tid >> 2, kc = tid & 3;
  const bf16_t* a0p = A0 + (size_t)lr * lda + kc * 8;
  const bf16_t* a1p = A1 + (size_t)lr * lda + kc * 8;
  const bf16_t* bp = Bt + (size_t)lr * ldb + kc * 8;
  const size_t sa = (size_t)64 * lda, sb = (size_t)64 * ldb;
  uint4 pa0, pa1, pc0, pc1, pb0, pb1, qa0, qa1, qc0, qc1, qb0, qb1;
#define GL2_(X, ko) do { X##a0 = *(const uint4*)(a0p + (ko)); X##a1 = *(const uint4*)(a0p + sa + (ko)); X##c0 = *(const uint4*)(a1p + (ko)); X##c1 = *(const uint4*)(a1p + sa + (ko)); \
    X##b0 = *(const uint4*)(bp + (ko)); X##b1 = *(const uint4*)(bp + sb + (ko)); } while (0)
#define ST2_(X, buf) do { bf16_t* d_ = L + (buf) * STG + wr_off; *(uint4*)(d_) = X##a0; *(uint4*)(d_ + 64 * LD2) = X##a1; *(uint4*)(d_ + 128 * LD2) = X##c0; *(uint4*)(d_ + 192 * LD2) = X##c1; \
    *(uint4*)(d_ + 256 * LD2) = X##b0; *(uint4*)(d_ + 320 * LD2) = X##b1; } while (0)
#define LF2_(S, ks) do { S##a0 = *(const bf16x8*)(Lc + 16 * (ks)); S##a1 = *(const bf16x8*)(Lc + 128 * LD2 + 16 * (ks)); \
      S##b0 = *(const bf16x8*)(Lc + rdb + 16 * (ks)); S##b1 = *(const bf16x8*)(Lc + rdb + 32 * LD2 + 16 * (ks)); S##b2 = *(const bf16x8*)(Lc + rdb + 64 * LD2 + 16 * (ks)); S##b3 = *(const bf16x8*)(Lc + rdb + 96 * LD2 + 16 * (ks)); } while (0)
#define MF2_(S) do { __builtin_amdgcn_s_setprio(1); \
      acc0[0] = __builtin_amdgcn_mfma_f32_32x32x16_bf16(S##a0, S##b0, acc0[0], 0, 0, 0); acc1[0] = __builtin_amdgcn_mfma_f32_32x32x16_bf16(S##a1, S##b0, acc1[0], 0, 0, 0); \
      acc0[1] = __builtin_amdgcn_mfma_f32_32x32x16_bf16(S##a0, S##b1, acc0[1], 0, 0, 0); acc1[1] = __builtin_amdgcn_mfma_f32_32x32x16_bf16(S##a1, S##b1, acc1[1], 0, 0, 0); \
      acc0[2] = __builtin_amdgcn_mfma_f32_32x32x16_bf16(S##a0, S##b2, acc0[2], 0, 0, 0); acc1[2] = __builtin_amdgcn_mfma_f32_32x32x16_bf16(S##a1, S##b2, acc1[2], 0, 0, 0); \
      acc0[3] = __builtin_amdgcn_mfma_f32_32x32x16_bf16(S##a0, S##b3, acc0[3], 0, 0, 0); acc1[3] = __builtin_amdgcn_mfma_f32_32x32x16_bf16(S##a1, S##b3, acc1[3], 0, 0, 0); \
      __builtin_amdgcn_s_setprio(0); } while (0)
#define MMA2_(buf) do { const bf16_t* Lc = L + (buf) * STG + rd_off; \
    LF2_(fx, 0); __builtin_amdgcn_sched_barrier(0); LF2_(fy, 1); __builtin_amdgcn_sched_barrier(0); \
    MF2_(fx); __builtin_amdgcn_sched_barrier(0); MF2_(fy); __builtin_amdgcn_sched_barrier(0); } while (0)
  bf16x8 fxa0, fxa1, fxb0, fxb1, fxb2, fxb3, fya0, fya1, fyb0, fyb1, fyb2, fyb3;
  GL2_(p, 0);
  const int nk = K >> 5;
  const int fr = lane & 31, fh = lane >> 5;
  const int rd_off = (32 * w + fr) * LD2 + 8 * fh;
  const int rdb = (256 + fr - 32 * w - fr) * LD2;
  const int wr_off = lr * LD2 + kc * 8;
  GL2_(q, 32);
  ST2_(p, 0);
  __syncthreads();
#pragma unroll 1
  for (int kt = 0; kt < nk; kt += 2) {
    { const int ko = min(kt + 2, nk - 1) * 32; GL2_(p, ko); }
    MMA2_(0);
    ST2_(q, 1);
    __syncthreads();
    { const int ko = min(kt + 3, nk - 1) * 32; GL2_(q, ko); }
    MMA2_(1);
    if (kt + 2 < nk) ST2_(p, 0);
    __syncthreads();
  }
#undef GL2_
#undef ST2_
#undef MMA2_
#undef LF2_
#undef MF2_
}

template <int TN> DEVI void zero_acc(f32x16 (&acc)[TN]) {
#pragma unroll
  for (int n = 0; n < TN; ++n)
#pragma unroll
    for (int r = 0; r < 16; ++r) acc[n][r] = 0.f;
}

#define ROW_OF(r) (32 * w + ((r) & 3) + 8 * ((r) >> 2) + 4 * fh)

constexpr int OLD = 136;
constexpr int OLF = 132;
DEVI void epi_store(const f32x16 (&acc)[4], bf16_t* ot, bool act, int ncols_tiles) {
  const int lane = tid_() & 63, w = tid_() >> 6, fr = lane & 31, fh = lane >> 5;
  bf16_t* o = ot + (32 * w + 4 * fh) * OLD + fr;
#pragma unroll
  for (int n = 0; n < 4; ++n) {
    if (n < ncols_tiles) {
#pragma unroll
      for (int r = 0; r < 16; ++r) { float v = acc[n][r]; if (act) v = siluf_(v); o[((r & 3) + 8 * (r >> 2)) * OLD + 32 * n] = f2bf(v); }
    }
  }
}

DEVI void epi_qknorm(const f32x16 (&acc)[4], const float* __restrict__ gain, float scale, bf16_t* ot) {
  const int lane = tid_() & 63, w = tid_() >> 6, fr = lane & 31, fh = lane >> 5;
  const float g0 = gain[fr] * scale, g1 = gain[32 + fr] * scale;
  bf16_t* o = ot + (32 * w + 4 * fh) * OLD + fr;
#pragma unroll
  for (int hh = 0; hh < 2; ++hh) {
    float sq[16];
#pragma unroll
    for (int r = 0; r < 16; ++r) { const float v0 = acc[2 * hh][r], v1 = acc[2 * hh + 1][r]; sq[r] = v0 * v0 + v1 * v1; }
#pragma unroll
    for (int r = 0; r < 16; ++r) sq[r] += shx<1>(sq[r]);
#pragma unroll
    for (int r = 0; r < 16; ++r) sq[r] += shx<2>(sq[r]);
#pragma unroll
    for (int r = 0; r < 16; ++r) sq[r] += shx<4>(sq[r]);
#pragma unroll
    for (int r = 0; r < 16; ++r) sq[r] += shx<8>(sq[r]);
#pragma unroll
    for (int r = 0; r < 16; ++r) sq[r] += shx<16>(sq[r]);
#pragma unroll
    for (int r = 0; r < 16; ++r) {
      const float rs = rsqrtf(sq[r] * (1.f / 64.f) + EPS_);
      bf16_t* d = o + ((r & 3) + 8 * (r >> 2)) * OLD + 64 * hh;
      d[0] = f2bf(acc[2 * hh][r] * rs * g0); d[32] = f2bf(acc[2 * hh + 1][r] * rs * g1);
    }
  }
}

DEVI void epi_vt(const f32x16& a0, const f32x16& a1, bf16_t* ot, int dvbase) {
  const int lane = tid_() & 63, w = tid_() >> 6, fr = lane & 31, fh = lane >> 5;
#pragma unroll
  for (int g = 0; g < 4; ++g) {
    const int so = 32 * w + 8 * g + 4 * fh;
    uint2 v0, v1;
    v0.x = cvt_pk_bf16(a0[4 * g], a0[4 * g + 1]); v0.y = cvt_pk_bf16(a0[4 * g + 2], a0[4 * g + 3]);
    v1.x = cvt_pk_bf16(a1[4 * g], a1[4 * g + 1]); v1.y = cvt_pk_bf16(a1[4 * g + 2], a1[4 * g + 3]);
    *(uint2*)(ot + (dvbase + fr) * OLD + so) = v0;
    *(uint2*)(ot + (dvbase + 32 + fr) * OLD + so) = v1;
  }
}

template <int NCH> DEVI void copy_out(const bf16_t* ot, bf16_t* dst, size_t ld, int nrows) {
  __syncthreads();
  const int total = nrows * NCH;
  for (int id = tid_(); id < total; id += 256) { const int row = id / NCH, ch = id - row * NCH; *(uint4*)(dst + (size_t)row * ld + ch * 8) = *(const uint4*)(ot + row * OLD + ch * 8); }
  __syncthreads();
}

DEVI void stage_f32(const f32x16 (&v)[4], float* of) {
  const int lane = tid_() & 63, w = tid_() >> 6, fr = lane & 31, fh = lane >> 5;
  float* o = of + (32 * w + 4 * fh) * OLF + fr;
#pragma unroll
  for (int n = 0; n < 4; ++n)
#pragma unroll
    for (int r = 0; r < 16; ++r) o[((r & 3) + 8 * (r >> 2)) * OLF + 32 * n] = v[n][r];
}
DEVI void residual_out(const float* of, const float* hin, float* out  ) {
  const int tid = tid_();
  f32x4 hv[16];
#pragma unroll
  for (int i = 0; i < 16; ++i) { const int id = tid + 256 * i, row = id >> 5, ch = id & 31; hv[i] = *(const f32x4*)(hin + (size_t)row * 1024 + ch * 4); }
  __syncthreads();
#pragma unroll
  for (int i = 0; i < 16; ++i) { const int id = tid + 256 * i, row = id >> 5, ch = id & 31;
    *(f32x4*)(out + (size_t)row * 1024 + ch * 4) = hv[i] + *(const f32x4*)(of + row * OLF + ch * 4); }
  __syncthreads();
}

DEVI void transpose_tile(const float* __restrict__ src, int ldsrc, int nsrc_valid, int n_src0, int k0, const float* __restrict__ gain,
                         bf16_t* __restrict__ dst, int K, int n_dst0, unsigned char* smem) {
  bf16_t* tl = (bf16_t*)smem;
  const int tid = tid_();
  const int n = tid & 31, kk = tid >> 5;
#pragma unroll
  for (int j = 0; j < 8; ++j) {
    const int k = kk + 8 * j;
    float v = 0.f;
    if (n_src0 >= 0 && (n_src0 + n) < nsrc_valid) { v = src[(size_t)(k0 + k) * ldsrc + n_src0 + n]; if (gain) v *= gain[k0 + k]; }
    tl[n * LDT + k] = f2bf(v);
  }
  __syncthreads();
  { const int nn = tid >> 3, kc = tid & 7;
    *(uint4*)(dst + (size_t)(n_dst0 + nn) * K + k0 + kc * 8) = *(const uint4*)(tl + nn * LDT + kc * 8); }
  __syncthreads();
}

DEVI void transpose_weight(const float* __restrict__ src, int Ksz, int Nsrc, int Ndst, const float* __restrict__ gain, bf16_t* __restrict__ dst, int remap_ab, unsigned char* smem) {
  const int nkt = Ksz / 64, nnt = Ndst / 32, total = nkt * nnt;
  bf16_t* tl = (bf16_t*)smem;
  const int tid = tid_();
  const int n = tid & 31, kk = tid >> 5;
  float v[8], vn[8];
  auto src_col = [&](int d0) { int s0 = d0; if (remap_ab) { if (d0 < 640) s0 = d0; else if (d0 < 3200) s0 = d0 + 32; else if (d0 < 3232) s0 = 640; else s0 = -1; } else if (d0 >= Nsrc) s0 = -1; return s0; };
#define TLOAD_(dstv, it_) do { const int nt_ = (it_) / nkt, kt_ = (it_) - nt_ * nkt; const int s0_ = src_col(nt_ * 32); const bool ok_ = (s0_ >= 0) && ((s0_ + n) < Nsrc); \
    _Pragma("unroll") for (int j = 0; j < 8; ++j) { const int k_ = kt_ * 64 + kk + 8 * j; float x_ = 0.f; if (ok_) { x_ = src[(size_t)k_ * Nsrc + s0_ + n]; if (gain) x_ *= gain[k_]; } dstv[j] = x_; } } while (0)
  int it = blockIdx.x;
  if (it < total) TLOAD_(v, it);
  for (; it < total; it += gridDim.x) {
    const int nt = it / nkt, kt = it - nt * nkt, d0 = nt * 32, k0 = kt * 64;
    const int itn = it + gridDim.x;
    if (itn < total) TLOAD_(vn, itn);
#pragma unroll
    for (int j = 0; j < 8; ++j) tl[n * LDT + kk + 8 * j] = f2bf(v[j]);
    __syncthreads();
    { const int nn = tid >> 3, kc = tid & 7;
      *(uint4*)(dst + (size_t)(d0 + nn) * Ksz + k0 + kc * 8) = *(const uint4*)(tl + nn * LDT + kc * 8); }
    __syncthreads();
#pragma unroll
    for (int j = 0; j < 8; ++j) v[j] = vn[j];
  }
#undef TLOAD_
}

DEVI void norm_rows(const float* __restrict__ src, const float* __restrict__ gain, bf16_t* __restrict__ dst) {
  const int lane = tid_() & 63, w = tid_() >> 6;
  f32x4 g[4];
#pragma unroll
  for (int j = 0; j < 4; ++j) g[j] = *(const f32x4*)(gain + (j * 64 + lane) * 4);
  for (int it = blockIdx.x; it < T_ / 16; it += gridDim.x) {
    const int row0 = it * 16 + w * 4;
    f32x4 v[4][4]; float sq[4];
#pragma unroll
    for (int rr = 0; rr < 4; ++rr)
#pragma unroll
      for (int j = 0; j < 4; ++j) v[rr][j] = *(const f32x4*)(src + (size_t)(row0 + rr) * 1024 + (j * 64 + lane) * 4);
#pragma unroll
    for (int rr = 0; rr < 4; ++rr) {
      float a = 0.f;
#pragma unroll
      for (int j = 0; j < 4; ++j) a += v[rr][j][0] * v[rr][j][0] + v[rr][j][1] * v[rr][j][1] + v[rr][j][2] * v[rr][j][2] + v[rr][j][3] * v[rr][j][3];
      sq[rr] = a;
    }
#pragma unroll
    for (int rr = 0; rr < 4; ++rr) sq[rr] += shx<1>(sq[rr]);
#pragma unroll
    for (int rr = 0; rr < 4; ++rr) sq[rr] += shx<2>(sq[rr]);
#pragma unroll
    for (int rr = 0; rr < 4; ++rr) sq[rr] += shx<4>(sq[rr]);
#pragma unroll
    for (int rr = 0; rr < 4; ++rr) sq[rr] += shx<8>(sq[rr]);
#pragma unroll
    for (int rr = 0; rr < 4; ++rr) sq[rr] += shx<16>(sq[rr]);
#pragma unroll
    for (int rr = 0; rr < 4; ++rr) sq[rr] += shx<32>(sq[rr]);
#pragma unroll
    for (int rr = 0; rr < 4; ++rr) {
      const float rs = rsqrtf(sq[rr] * (1.f / 1024.f) + EPS_);
#pragma unroll
      for (int j = 0; j < 4; ++j) {
        uint2 o; o.x = cvt_pk_bf16(v[rr][j][0] * rs * g[j][0], v[rr][j][1] * rs * g[j][1]); o.y = cvt_pk_bf16(v[rr][j][2] * rs * g[j][2], v[rr][j][3] * rs * g[j][3]);
        *(uint2*)(dst + (size_t)(row0 + rr) * 1024 + (j * 64 + lane) * 4) = o;
      }
    }
  }
}

DEVI void phase_prep(const Params& P, int layer, unsigned char* smem) {
  const int l = layer >> 1;
  const float* hin = layer == 0 ? P.x : P.out;
  norm_rows(hin, P.norm_g + layer * 1024, P.uy);
  if ((layer & 1) == 0) {
    transpose_weight(P.ab_w_in + (size_t)l * 1024 * 3232, 1024, 3232, 3328, nullptr, P.wt_in, 1, smem);
    transpose_weight(P.mla_w_uq + (size_t)l * 384 * 768, 384, 768, 768, P.mla_q_norm + l * 384, P.wt_uq, 0, smem);
    transpose_weight(P.mla_w_ukv + (size_t)l * 256 * 1024, 256, 1024, 1024, P.mla_kv_norm + l * 256, P.wt_ukv, 0, smem);
    transpose_weight(P.ab_w_out + (size_t)l * 1024 * 1024, 1024, 1024, 1024, nullptr, P.wt_out, 0, smem);
  } else {
    transpose_weight(P.fox_w_in + (size_t)l * 1024 * 4112, 1024, 4112, 4224, nullptr, P.wt_in, 0, smem);
    transpose_weight(P.fox_w_out + (size_t)l * 1024 * 1024, 1024, 1024, 1024, nullptr, P.wt_out, 0, smem);
  }
  transpose_weight(P.pe_w + (size_t)layer * 256 * 1024, 256, 1024, 1024, nullptr, P.wt_pe, 0, smem);
  transpose_weight(P.pe_gate_w + (size_t)layer * 1024 * 1024, 1024, 1024, 1024, P.pe_gate_norm + layer * 1024, P.wt_gate, 0, smem);
  if (layer == 0) {
    for (int it = blockIdx.x; it < T_ * 16 / 256; it += gridDim.x) {
      const int e = it * 256 + tid_(), tok = e >> 4, i = e & 15;
      double invf = 1.0;
      for (int q = 0; q < i; ++q) invf *= 0.5623413251903491;
      const double rev = (double)P.pos[tok] * invf * 0.15915494309189535;
      const float fr = (float)(rev - floor(rev));
      P.cosT[e] = __builtin_amdgcn_cosf(fr); P.sinT[e] = __builtin_amdgcn_sinf(fr);
    }
  }
}

DEVI void epi_in_even(const Params& P, int l, const f32x16 (&acc)[4], int rt, int ct, unsigned char* smem) {
  const int row0 = rt * 128;
  bf16_t* zr = P.z + (size_t)row0 * ZE;
  bf16_t* ot = (bf16_t*)smem;
  if (ct < 5) { epi_store(acc, ot, false, 4); copy_out<16>(ot, zr + ct * 128, ZE, 128); }
  else if (ct < 9) { epi_store(acc, ot, true, 4); copy_out<16>(ot, zr + ct * 128, ZE, 128); }
  else if (ct < 13) { epi_qknorm(acc, P.chk_q_gain + l * 64, 0.125f * LOG2E_, ot); copy_out<16>(ot, zr + ct * 128, ZE, 128); }
  else if (ct < 17) { epi_qknorm(acc, P.chk_k_gain + l * 64, 1.f, ot); copy_out<16>(ot, zr + ct * 128, ZE, 128); }
  else if (ct < 21) {
    const int b = row0 / S_, s0 = row0 % S_, hd = (ct - 17) * 2;
    epi_vt(acc[0], acc[1], ot, 0); epi_vt(acc[2], acc[3], ot, 64);
    copy_out<16>(ot, P.vt + ((size_t)(b * 8 + hd) * 64) * S_ + s0, S_, 128);
  }
  else if (ct < 25) { epi_store(acc, ot, true, 4); copy_out<16>(ot, zr + ct * 128 - 512, ZE, 128); }
  else { epi_store(acc, ot, false, 1); copy_out<4>(ot, zr + 2688, ZE, 128); }
}
DEVI void phase_in_even(const Params& P, int l, unsigned char* smem) {
  constexpr int NCT = 26, NPAIR = 1536;
  const int G = gridDim.x;
  TileIter ti; tile_begin(ti, NCT, 64, NPAIR);
  for (int rp, ct; tile_next(ti, rp, ct);) {
    f32x16 acc0[4], acc1[4]; zero_acc<4>(acc0); zero_acc<4>(acc1);
    gemm_mainloop2(P.uy + (size_t)(2 * rp) * 128 * 1024, P.uy + (size_t)(2 * rp + 1) * 128 * 1024, 1024, P.wt_in + (size_t)ct * 128 * 1024, 1024, 1024, acc0, acc1, smem);
    epi_in_even(P, l, acc0, 2 * rp, ct, smem);
    epi_in_even(P, l, acc1, 2 * rp + 1, ct, smem);
  }
  for (int s = blockIdx.x; s < 2 * (64 * NCT - NPAIR); s += G) {
    int rp, ct; decode_item(NPAIR + (s >> 1), NCT, 64, rp, ct);
    const int rt = 2 * rp + (s & 1);
    f32x16 acc[4]; zero_acc<4>(acc); f32x4 ss;
    gemm_mainloop<128, false>(P.uy + (size_t)rt * 128 * 1024, 1024, P.wt_in + (size_t)ct * 128 * 1024, 1024, 1024, acc, smem, ss);
    epi_in_even(P, l, acc, rt, ct, smem);
  }
}

DEVI void epi_in_odd(const Params& P, int l, const f32x16 (&acc)[4], int rt, int ct, unsigned char* smem) {
  const int row0 = rt * 128;
  bf16_t* zr = P.z + (size_t)row0 * ZO;
  bf16_t* ot = (bf16_t*)smem;
  if (ct < 8) { epi_qknorm(acc, P.fox_q_gain + l * 64, 0.125f * LOG2E_, ot); copy_out<16>(ot, zr + ct * 128, ZO, 128); }
  else if (ct < 16) { epi_qknorm(acc, P.fox_k_gain + l * 64, 1.f, ot); copy_out<16>(ot, zr + ct * 128, ZO, 128); }
  else if (ct < 24) {
    const int b = row0 / S_, s0 = row0 % S_, hd = (ct - 16) * 2;
    epi_vt(acc[0], acc[1], ot, 0); epi_vt(acc[2], acc[3], ot, 64);
    copy_out<16>(ot, P.vt + ((size_t)(b * 16 + hd) * 64) * S_ + s0, S_, 128);
  }
  else if (ct < 32) { epi_store(acc, ot, true, 4); copy_out<16>(ot, zr + (ct - 24) * 128 + 2048, ZO, 128); }
  else {
    const int lane = tid_() & 63, w = tid_() >> 6, fr = lane & 31, fh = lane >> 5;
    if (fr < 16) {
      const float bf = P.fox_b_f[l * 16 + fr];
#pragma unroll
      for (int r = 0; r < 16; ++r) {
        const float xv = acc[0][r] + bf;
        const float ls = fminf(xv, 0.f) - log1pf(expf(-fabsf(xv)));
        int orow = ROW_OF(r); asm volatile("" : "+v"(orow));
        P.logf[(size_t)(row0 + orow) * 16 + fr] = ls * LOG2E_;
        FENCE();
      }
    }
  }
}
DEVI void phase_in_odd(const Params& P, int l, unsigned char* smem) {
  const int G = gridDim.x;
  TileIter ti; tile_begin(ti, 32, 64);
  for (int rp, ct; tile_next(ti, rp, ct);) {
    f32x16 acc0[4], acc1[4]; zero_acc<4>(acc0); zero_acc<4>(acc1);
    gemm_mainloop2(P.uy + (size_t)(2 * rp) * 128 * 1024, P.uy + (size_t)(2 * rp + 1) * 128 * 1024, 1024, P.wt_in + (size_t)ct * 128 * 1024, 1024, 1024, acc0, acc1, smem);
    epi_in_odd(P, l, acc0, 2 * rp, ct, smem);
    epi_in_odd(P, l, acc1, 2 * rp + 1, ct, smem);
  }
  for (int rt = blockIdx.x; rt < 128; rt += G) {
    f32x16 acc[4]; zero_acc<4>(acc); f32x4 ss;
    f32x16 (&acc1)[1] = *(f32x16 (*)[1])&acc[0];
    gemm_mainloop<32, false>(P.uy + (size_t)rt * 128 * 1024, 1024, P.wt_in + (size_t)32 * 128 * 1024, 1024, 1024, acc1, smem, ss);
    epi_in_odd(P, l, acc, rt, 32, smem);
  }
}

DEVI void phase_mla_up(const Params& P, int l, unsigned char* smem) {
  const int G = gridDim.x;
  float* rowstat = (float*)(smem + 73728);
  bf16_t* ot = (bf16_t*)smem;
  const int tid = tid_(), lane = tid & 63, w = tid >> 6, fr = lane & 31, fh = lane >> 5;
  for (int tile = vbid(); tile < 2048; tile += G) {
    const bool isq = tile < 1024;
    const int tt = isq ? tile : tile - 1024;
    const int rt = tt >> 3, hd = tt & 7;
    const int row0 = rt * 128, b = row0 / S_, s0 = row0 % S_;
    f32x4 ss;
    if (isq) {
      f32x16 acc[3]; zero_acc<3>(acc);
      gemm_mainloop<96, true, false>(P.z + (size_t)row0 * ZE, ZE, P.wt_uq + (size_t)hd * 96 * 384, 384, 384, acc, smem, ss);
#pragma unroll
      for (int i = 0; i < 4; ++i) { float v = ss[i]; v += shx<1>(v); v += shx<2>(v); v += shx<4>(v); if ((tid & 7) == 0) rowstat[(tid >> 3) + 32 * i] = rsqrtf(v * (1.f / 384.f) + EPS_); }
      __syncthreads();
      const float g0 = P.mla_q_gain[l * 96 + fr], g1 = P.mla_q_gain[l * 96 + 32 + fr], g2 = P.mla_q_gain[l * 96 + 64 + fr];
      const float qs = 0.10206207261596577f * LOG2E_;
      bf16_t* qd = P.qm + ((size_t)(b * 8 + hd) * S_ + s0) * 96;
      float cs[16], sn_[16];
#pragma unroll
      for (int r = 0; r < 16; ++r) { const size_t ti = (size_t)(row0 + ROW_OF(r)) * 16 + (fr & 15); cs[r] = P.cosT[ti]; sn_[r] = P.sinT[ti]; }
#pragma unroll
      for (int r = 0; r < 16; ++r) {
        const int row = ROW_OF(r);
        const float rs = rowstat[row];
        const float v0 = acc[0][r] * rs, v1 = acc[1][r] * rs, v2 = acc[2][r] * rs;
        const float sq = hsum32(v0 * v0 + v1 * v1 + v2 * v2);
        const float r2 = rsqrtf(sq * (1.f / 96.f) + EPS_) * qs;
        const float q0 = v0 * r2 * g0, q1 = v1 * r2 * g1, q2 = v2 * r2 * g2;
        const float pr = shx<16>(q2);
        const float c = cs[r], sn = sn_[r];
        const float q2r = (fr < 16) ? q2 * c - pr * sn : q2 * c + pr * sn;
        bf16_t* d = ot + row * OLD + fr;
        d[0] = f2bf(q0); d[32] = f2bf(q1); d[64] = f2bf(q2r);
      }
      copy_out<12>(ot, qd, 96, 128);
    } else {
      f32x16 acc[4]; zero_acc<4>(acc);
      gemm_mainloop<128, true, false>(P.z + (size_t)row0 * ZE + 384, ZE, P.wt_ukv + (size_t)hd * 128 * 256, 256, 256, acc, smem, ss);
#pragma unroll
      for (int i = 0; i < 4; ++i) { float v = ss[i]; v += shx<1>(v); v += shx<2>(v); v += shx<4>(v); if ((tid & 7) == 0) rowstat[(tid >> 3) + 32 * i] = rsqrtf(v * (1.f / 256.f) + EPS_); }
      __syncthreads();
      const float g0 = P.mla_k_gain[l * 96 + fr], g1 = P.mla_k_gain[l * 96 + 32 + fr], g2 = P.mla_k_gain[l * 96 + 64 + fr];
      bf16_t* kd = P.km + ((size_t)(b * 8 + hd) * S_ + s0) * 96;
      float cs[16], sn_[16], krv[16];
#pragma unroll
      for (int r = 0; r < 16; ++r) { const size_t ti = (size_t)(row0 + ROW_OF(r)) * 16 + (fr & 15); cs[r] = P.cosT[ti]; sn_[r] = P.sinT[ti];
        krv[r] = bf2f(P.z[(size_t)(row0 + ROW_OF(r)) * ZE + 2688 + fr]); }
#pragma unroll
      for (int r = 0; r < 16; ++r) {
        const int row = ROW_OF(r);
        const float rs = rowstat[row];
        const float v0 = acc[0][r] * rs, v1 = acc[1][r] * rs;
        acc[2][r] *= rs; acc[3][r] *= rs;
        const float kr = krv[r];
        const float sq = hsum32(v0 * v0 + v1 * v1 + kr * kr);
        const float r2 = rsqrtf(sq * (1.f / 96.f) + EPS_);
        const float k0 = v0 * r2 * g0, k1 = v1 * r2 * g1, k2 = kr * r2 * g2;
        const float pr = shx<16>(k2);
        const float c = cs[r], sn = sn_[r];
        const float k2r = (fr < 16) ? k2 * c - pr * sn : k2 * c + pr * sn;
        bf16_t* d = ot + row * OLD + fr;
        d[0] = f2bf(k0); d[32] = f2bf(k1); d[64] = f2bf(k2r);
      }
      epi_vt(acc[2], acc[3], ot + 128 * OLD, 0);
      copy_out<12>(ot, kd, 96, 128);
      copy_out<16>(ot + 128 * OLD, P.vtm + ((size_t)(b * 8 + hd) * 64) * S_ + s0, S_, 64);
    }
  }
}

DEVI void phase_scan(const Params& P, unsigned char* smem) {
  double* tot = (double*)smem;
  const int tid = tid_();
  for (int seq = blockIdx.x; seq < 32; seq += gridDim.x) {
    const int b = seq >> 4, h = seq & 15;
    const float* lp = P.logf + ((size_t)b * S_ + tid * 32) * 16 + h;
    float lv[32];
#pragma unroll
    for (int j = 0; j < 32; ++j) lv[j] = lp[(size_t)j * 16];
    double a = 0.0;
#pragma unroll
    for (int j = 0; j < 32; ++j) a += (double)lv[j];
    tot[tid] = a;
    __syncthreads();
    double off = 0.0;
    for (int j = 0; j < tid; ++j) off += tot[j];
    float* cp = P.cum + (size_t)seq * S_ + tid * 32;
#pragma unroll
    for (int j = 0; j < 32; j += 4) {
      f32x4 o4;
#pragma unroll
      for (int q = 0; q < 4; ++q) { off += (double)lv[j + q]; o4[q] = (float)off; }
      *(f32x4*)(cp + j) = o4;
    }
    __syncthreads();
  }
}

template <int DK, int MODE>
DEVI void attn_unit(const Params& P, int l, int b, int hd, int qb, unsigned char* smem) {
  constexpr int LDK = DK + 8, NKS = DK / 16, KCH = DK / 8, NKL = (64 * KCH) / 256;
  bf16_t* Ks = (bf16_t*)smem;
  bf16_t* Vs = Ks + 2 * 64 * LDK;
  float* ckS = (float*)(Vs + 2 * 64 * LDT);
  float* tbl = ckS + 128;
  const int tid = tid_(), lane = tid & 63, w = tid >> 6, fr = lane & 31, fh = lane >> 5;
  const int q0 = qb * 128;
  const size_t tok0 = (size_t)b * S_;
  const bf16_t *Qp, *Kp, *Vp, *Gp; int ldq, ldk, ldg; bf16_t* Yp; const float* cump = nullptr;
  if (MODE == 0) {
    Qp = P.qm + ((size_t)(b * 8 + hd) * S_) * 96; ldq = 96; Kp = P.km + ((size_t)(b * 8 + hd) * S_) * 96; ldk = 96;
    Vp = P.vtm + ((size_t)(b * 8 + hd) * 64) * S_; Gp = P.z + tok0 * ZE + 640 + hd * 64; ldg = ZE; Yp = P.uy + tok0 * 1024 + hd * 64;
  } else if (MODE == 1) {
    Qp = P.z + tok0 * ZE + 1152 + hd * 64; ldq = ZE; Kp = P.z + tok0 * ZE + 1664 + hd * 64; ldk = ZE;
    Vp = P.vt + ((size_t)(b * 8 + hd) * 64) * S_; Gp = P.z + tok0 * ZE + 2176 + hd * 64; ldg = ZE; Yp = P.uy + tok0 * 1024 + 512 + hd * 64;
  } else {
    Qp = P.z + tok0 * ZO + hd * 64; ldq = ZO; Kp = P.z + tok0 * ZO + 1024 + hd * 64; ldk = ZO;
    Vp = P.vt + ((size_t)(b * 16 + hd) * 64) * S_; Gp = P.z + tok0 * ZO + 2048 + hd * 64; ldg = ZO; Yp = P.uy + tok0 * 1024 + hd * 64;
    cump = P.cum + (size_t)(b * 16 + hd) * S_;
  }
  int kt_begin = (MODE == 1) ? max(0, 2 * qb - 8) : 0;
  float qkb2 = 0.f;
  const int kt_end = 2 * qb + 2;
  if (MODE == 2) {
    float gq = fabsf(P.fox_q_gain[l * 64 + lane]), gk = fabsf(P.fox_k_gain[l * 64 + lane]);
    gq = fmaxf(gq, shx<1>(gq)); gq = fmaxf(gq, shx<2>(gq)); gq = fmaxf(gq, shx<4>(gq)); gq = fmaxf(gq, shx<8>(gq)); gq = fmaxf(gq, shx<16>(gq)); gq = fmaxf(gq, shx<32>(gq));
    gk = fmaxf(gk, shx<1>(gk)); gk = fmaxf(gk, shx<2>(gk)); gk = fmaxf(gk, shx<4>(gk)); gk = fmaxf(gk, shx<8>(gk)); gk = fmaxf(gk, shx<16>(gk)); gk = fmaxf(gk, shx<32>(gk));
    qkb2 = 8.f * gq * gk * LOG2E_ * 1.05f;
    const float thr = 2.f * qkb2 + 40.f;
    int* skb = (int*)(tbl + 520);
    if (tid == 0) *skb = 2 * qb;
    __syncthreads();
    if (tid < 2 * qb) { if (!((cump[64 * tid + 63] - cump[q0]) > thr)) atomicMin(skb, tid); }
    __syncthreads();
    kt_begin = *skb;
  }
  const int qc = 2 * qb + (w >> 1);
  bf16x8 qf[NKS];
  { const bf16_t* qp = Qp + (size_t)(q0 + 32 * w + fr) * ldq + 8 * fh;
#pragma unroll
    for (int ks = 0; ks < NKS; ++ks) qf[ks] = *(const bf16x8*)(qp + 16 * ks); }
  float cq2 = 0.f;
  if (MODE == 2) cq2 = cump[q0 + 32 * w + fr];
  if (MODE == 1) {
    for (int i = tid; i < 513; i += 256) tbl[i] = P.chk_rel_bias[((size_t)l * 8 + hd) * 513 + i] * LOG2E_;
    float gq = fabsf(P.chk_q_gain[l * 64 + lane]), gk = fabsf(P.chk_k_gain[l * 64 + lane]), bm = 0.f;
    for (int i = lane; i < 513; i += 64) bm = fmaxf(bm, fabsf(P.chk_rel_bias[((size_t)l * 8 + hd) * 513 + i]));
    gq = fmaxf(gq, shx<1>(gq)); gq = fmaxf(gq, shx<2>(gq)); gq = fmaxf(gq, shx<4>(gq)); gq = fmaxf(gq, shx<8>(gq)); gq = fmaxf(gq, shx<16>(gq)); gq = fmaxf(gq, shx<32>(gq));
    gk = fmaxf(gk, shx<1>(gk)); gk = fmaxf(gk, shx<2>(gk)); gk = fmaxf(gk, shx<4>(gk)); gk = fmaxf(gk, shx<8>(gk)); gk = fmaxf(gk, shx<16>(gk)); gk = fmaxf(gk, shx<32>(gk));
    bm = fmaxf(bm, shx<1>(bm)); bm = fmaxf(bm, shx<2>(bm)); bm = fmaxf(bm, shx<4>(bm)); bm = fmaxf(bm, shx<8>(bm)); bm = fmaxf(bm, shx<16>(bm)); bm = fmaxf(bm, shx<32>(bm));
    qkb2 = (8.f * gq * gk * 1.05f + bm) * LOG2E_;
  }
  if (MODE == 0) {
    float gq = fmaxf(fabsf(P.mla_q_gain[l * 96 + lane]), fabsf(P.mla_q_gain[l * 96 + 32 + lane])), gk = fmaxf(fabsf(P.mla_k_gain[l * 96 + lane]), fabsf(P.mla_k_gain[l * 96 + 32 + lane]));
    gq = fmaxf(gq, shx<1>(gq)); gq = fmaxf(gq, shx<2>(gq)); gq = fmaxf(gq, shx<4>(gq)); gq = fmaxf(gq, shx<8>(gq)); gq = fmaxf(gq, shx<16>(gq)); gq = fmaxf(gq, shx<32>(gq));
    gk = fmaxf(gk, shx<1>(gk)); gk = fmaxf(gk, shx<2>(gk)); gk = fmaxf(gk, shx<4>(gk)); gk = fmaxf(gk, shx<8>(gk)); gk = fmaxf(gk, shx<16>(gk)); gk = fmaxf(gk, shx<32>(gk));
    qkb2 = 9.797958971f * gq * gk * LOG2E_ * 1.05f;
  }
  const bool fixedm = qkb2 <= 40.f;
  uint4 rk0, rk1, rk2, rv0, rv1; float rc = 0.f;
  rk2 = make_uint4(0, 0, 0, 0);
  const int kr0 = tid / KCH, kc0 = tid % KCH, kr1 = (tid + 256) / KCH, kc1 = (tid + 256) % KCH, kr2 = (tid + 512) / KCH, kc2 = (tid + 512) % KCH;
  const int vr0 = tid >> 3, vc0 = tid & 7;
#define AGL_(kt_) do { const int k0_ = (kt_) * 64; \
    rk0 = *(const uint4*)(Kp + (size_t)(k0_ + kr0) * ldk + kc0 * 8); rk1 = *(const uint4*)(Kp + (size_t)(k0_ + kr1) * ldk + kc1 * 8); \
    if (NKL > 2) rk2 = *(const uint4*)(Kp + (size_t)(k0_ + kr2) * ldk + kc2 * 8); \
    rv0 = *(const uint4*)(Vp + (size_t)vr0 * S_ + k0_ + vc0 * 8); rv1 = *(const uint4*)(Vp + (size_t)(vr0 + 32) * S_ + k0_ + vc0 * 8); \
    if (MODE == 2) { if (tid < 64) rc = cump[k0_ + tid]; } } while (0)
#define AST_(buf) do { bf16_t* k_ = Ks + (buf) * 64 * LDK; bf16_t* v_ = Vs + (buf) * 64 * LDT; \
    *(uint4*)(k_ + kr0 * LDK + kc0 * 8) = rk0; *(uint4*)(k_ + kr1 * LDK + kc1 * 8) = rk1; if (NKL > 2) *(uint4*)(k_ + kr2 * LDK + kc2 * 8) = rk2; \
    *(uint4*)(v_ + vr0 * LDT + vc0 * 8) = rv0; *(uint4*)(v_ + (vr0 + 32) * LDT + vc0 * 8) = rv1; \
    if (MODE == 2) { if (tid < 64) ckS[(buf) * 64 + tid] = rc; } } while (0)
  f32x16 o[2];
#pragma unroll
  for (int r = 0; r < 16; ++r) { o[0][r] = 0.f; o[1][r] = 0.f; }
  float m = fixedm ? qkb2 : -1e30f, lsum = 0.f;
  const float sbase = ((MODE == 2) ? cq2 : 0.f) - (fixedm ? qkb2 : 0.f);
  const int pfr = (fr & 0x13) | ((fr & 4) << 1) | ((fr & 8) >> 1);
  AGL_(kt_begin); AST_(0);
  __syncthreads();
#pragma unroll 1
  for (int kt = kt_begin; kt < kt_end; ++kt) {
    const int cur = (kt - kt_begin) & 1;
    if (kt + 1 < kt_end) AGL_(kt + 1);
    bool active;
    if (MODE == 0) active = kt <= qc;
    else if (MODE == 1) active = (kt <= qc) && (kt >= qc - 8);
    else active = (64 * kt) <= (q0 + 32 * w + 31);
    if (active) {
      f32x16 s[2];
      float sinit = sbase;
      bool farb = false;
      if (MODE == 1) { farb = (64 * (qc - kt) + 32 * (w & 1) - 63) >= 256; if (farb) sinit += tbl[512]; }
#pragma unroll
      for (int r = 0; r < 16; ++r) { s[0][r] = sinit; s[1][r] = sinit; }
      const bf16_t* Kc = Ks + cur * 64 * LDK + pfr * LDK + 8 * fh;
      {
        bf16x8 xa = *(const bf16x8*)(Kc), xb = *(const bf16x8*)(Kc + 32 * LDK);
#pragma unroll
        for (int ks = 0; ks < NKS; ++ks) {
          bf16x8 ya = xa, yb = xb;
          if (ks + 1 < NKS) { ya = *(const bf16x8*)(Kc + 16 * (ks + 1)); yb = *(const bf16x8*)(Kc + 32 * LDK + 16 * (ks + 1)); }
          __builtin_amdgcn_sched_barrier(0);
          s[0] = __builtin_amdgcn_mfma_f32_32x32x16_bf16(xa, qf[ks], s[0], 0, 0, 0);
          s[1] = __builtin_amdgcn_mfma_f32_32x32x16_bf16(xb, qf[ks], s[1], 0, 0, 0);
          __builtin_amdgcn_sched_barrier(0);
          xa = ya; xb = yb;
        }
      }
      if (MODE == 2) {
        const bool diag = (64 * kt + 63) > (q0 + 32 * w);
        const int qrel = q0 + 32 * w + fr - 64 * kt;
#pragma unroll
        for (int t = 0; t < 2; ++t)
#pragma unroll
          for (int g = 0; g < 4; ++g) {
            const int sb = 32 * t + 16 * (g >> 1) + 8 * fh + 4 * (g & 1);
            const f32x4 ck = *(const f32x4*)(ckS + cur * 64 + sb);
#pragma unroll
            for (int bb = 0; bb < 4; ++bb) {
              float v = s[t][4 * g + bb] - ck[bb];
              if (diag && (sb + bb) > qrel) v = -1e30f;
              s[t][4 * g + bb] = v;
            }
          }
      } else if (MODE == 1) {
        const int Dd = 64 * (qc - kt) + 32 * (w & 1) + fr;
        if (!farb) {
#pragma unroll
          for (int t = 0; t < 2; ++t)
#pragma unroll
            for (int r = 0; r < 16; ++r) {
              const int slot = 32 * t + 16 * (r >> 3) + 8 * fh + 4 * ((r >> 2) & 1) + (r & 3);
              const int idx = min(Dd - slot, 256) + 256;
              s[t][r] += tbl[idx];
            }
        }
      }
      float mx = m;
      if (!fixedm) {
        mx = fmaxf(s[0][0], s[1][0]);
#pragma unroll
        for (int r = 1; r < 16; ++r) mx = fmaxf(mx, fmaxf(s[0][r], s[1][r]));
        mx = fmaxf(mx, shx<32>(mx));
      }
      if (!fixedm && __builtin_amdgcn_ballot_w64(mx > m) != 0ull) {
        const float mn = fmaxf(m, mx);
        const float alpha = __builtin_amdgcn_exp2f(m - mn);
        m = mn; lsum *= alpha;
#pragma unroll
        for (int r = 0; r < 16; ++r) { o[0][r] *= alpha; o[1][r] *= alpha; }
      }
      float ps = 0.f;
      if (fixedm) {
#pragma unroll
        for (int t = 0; t < 2; ++t)
#pragma unroll
          for (int r = 0; r < 16; ++r) { const float pv = __builtin_amdgcn_exp2f(s[t][r]); s[t][r] = pv; ps += pv; }
      } else {
#pragma unroll
        for (int t = 0; t < 2; ++t)
#pragma unroll
          for (int r = 0; r < 16; ++r) { const float pv = __builtin_amdgcn_exp2f(s[t][r] - m); s[t][r] = pv; ps += pv; }
      }
      lsum += ps;
      const bf16_t* Vc = Vs + cur * 64 * LDT + fr * LDT + 8 * fh;
      {
        bf16x8 v0 = *(const bf16x8*)(Vc), v1 = *(const bf16x8*)(Vc + 32 * LDT);
#pragma unroll
        for (int i = 0; i < 4; ++i) {
          const int t = i >> 1, si = i & 1;
          bf16x8 n0 = v0, n1 = v1;
          if (i < 3) { const int t2 = (i + 1) >> 1, s2 = (i + 1) & 1; n0 = *(const bf16x8*)(Vc + 32 * t2 + 16 * s2); n1 = *(const bf16x8*)(Vc + 32 * LDT + 32 * t2 + 16 * s2); }
          u32x4 pku;
          pku[0] = cvt_pk_bf16(s[t][8 * si + 0], s[t][8 * si + 1]); pku[1] = cvt_pk_bf16(s[t][8 * si + 2], s[t][8 * si + 3]);
          pku[2] = cvt_pk_bf16(s[t][8 * si + 4], s[t][8 * si + 5]); pku[3] = cvt_pk_bf16(s[t][8 * si + 6], s[t][8 * si + 7]);
          const bf16x8 pkv = __builtin_bit_cast(bf16x8, pku);
          __builtin_amdgcn_sched_barrier(0);
          o[0] = __builtin_amdgcn_mfma_f32_32x32x16_bf16(v0, pkv, o[0], 0, 0, 0);
          o[1] = __builtin_amdgcn_mfma_f32_32x32x16_bf16(v1, pkv, o[1], 0, 0, 0);
          __builtin_amdgcn_sched_barrier(0);
          v0 = n0; v1 = n1;
        }
      }
    }
    if (kt + 1 < kt_end) AST_(cur ^ 1);
    __syncthreads();
  }
  lsum += shx<32>(lsum);
  const float inv = 1.f / lsum;
  const size_t trow = (size_t)(q0 + 32 * w + fr);
  uint2 ggv[2][4];
#pragma unroll
  for (int u = 0; u < 2; ++u)
#pragma unroll
    for (int g = 0; g < 4; ++g) ggv[u][g] = *(const uint2*)(Gp + trow * ldg + 32 * u + 8 * g + 4 * fh);
#pragma unroll
  for (int u = 0; u < 2; ++u)
#pragma unroll
    for (int g = 0; g < 4; ++g) {
      const int dv = 32 * u + 8 * g + 4 * fh;
      const uint2 gg = ggv[u][g];
      const float g0 = __uint_as_float(gg.x << 16), g1 = __uint_as_float(gg.x & 0xffff0000u), g2 = __uint_as_float(gg.y << 16), g3 = __uint_as_float(gg.y & 0xffff0000u);
      uint2 ov; ov.x = cvt_pk_bf16(o[u][4 * g] * inv * g0, o[u][4 * g + 1] * inv * g1); ov.y = cvt_pk_bf16(o[u][4 * g + 2] * inv * g2, o[u][4 * g + 3] * inv * g3);
      *(uint2*)(Yp + trow * 1024 + dv) = ov;
    }
}

DEVI int zigzag(int r, int G, int bid) { return r * G + ((r & 1) ? (G - 1 - bid) : bid); }

DEVI void phase_attn_even(const Params& P, int l, unsigned char* smem) {
  const int G = gridDim.x;
  for (int r = 0;; ++r) {
    const int j = zigzag(r, G, blockIdx.x);
    if (r * G >= 2048) break;
    if (j >= 2048) continue;
    if (j < 1024) { const int qb = 63 - (j >> 4), bh = j & 15; attn_unit<96, 0>(P, l, bh >> 3, bh & 7, qb, smem); }
    else { const int jj = j - 1024; const int qb = 63 - (jj >> 4), bh = jj & 15; attn_unit<64, 1>(P, l, bh >> 3, bh & 7, qb, smem); }
  }
}
DEVI void phase_attn_odd(const Params& P, int l, unsigned char* smem) {
  const int G = gridDim.x;
  for (int r = 0;; ++r) {
    const int j = zigzag(r, G, blockIdx.x);
    if (r * G >= 2048) break;
    if (j >= 2048) continue;
    const int qb = 63 - (j >> 5), bh = j & 31;
    attn_unit<64, 2>(P, l, bh >> 4, bh & 15, qb, smem);
  }
}

DEVI void phase_outproj(const Params& P, int layer, unsigned char* smem) {
  const float* hin = layer == 0 ? P.x : P.out;
  TileIter ti; tile_begin(ti, 8, 64);
  for (int rp, ct; tile_next(ti, rp, ct);) {
    f32x16 acc0[4], acc1[4]; zero_acc<4>(acc0); zero_acc<4>(acc1);
    gemm_mainloop2(P.uy + (size_t)(2 * rp) * 128 * 1024, P.uy + (size_t)(2 * rp + 1) * 128 * 1024, 1024, P.wt_out + (size_t)ct * 128 * 1024, 1024, 1024, acc0, acc1, smem);
    { stage_f32(acc0, (float*)smem); const size_t org = (size_t)(2 * rp * 128) * 1024 + ct * 128; residual_out((const float*)smem, hin + org, (float*)P.z + org); }
    { stage_f32(acc1, (float*)smem); const size_t org = (size_t)((2 * rp + 1) * 128) * 1024 + ct * 128; residual_out((const float*)smem, hin + org, (float*)P.z + org); }
  }
}

DEVI void phase_norm2(const Params& P, int layer) {
  norm_rows(P.out, P.pe_gate_norm + layer * 1024, P.uy);
  const float* pp = P.p + (size_t)layer * T_ * 256;
  for (int it = blockIdx.x; it < T_ * 256 / 2048; it += gridDim.x) {
    const size_t e = (size_t)it * 2048 + tid_() * 8;
    const f32x4 a = *(const f32x4*)(pp + e), c = *(const f32x4*)(pp + e + 4);
    uint4 o; o.x = cvt_pk_bf16(a[0], a[1]); o.y = cvt_pk_bf16(a[2], a[3]); o.z = cvt_pk_bf16(c[0], c[1]); o.w = cvt_pk_bf16(c[2], c[3]);
    *(uint4*)(P.pb + e) = o;
  }
}

DEVI void phase_ple(const Params& P, int layer, unsigned char* smem) {
  const int tid = tid_(), lane = tid & 63, w = tid >> 6, fh = lane >> 5;
  typedef _Float16 h2 __attribute__((ext_vector_type(2)));
  float* rowstat = (float*)(smem + 73728);
  const float* pp = P.p + (size_t)layer * T_ * 256;
  TileIter ti; tile_begin(ti, 8);
  for (int rt, ct; tile_next(ti, rt, ct);) {
    f32x4 ss;
    unsigned gp[4][8];
    {
      f32x16 gate[4]; zero_acc<4>(gate);
      gemm_mainloop_f32a<true>((const float*)P.z + (size_t)rt * 128 * 1024, 1024, P.wt_gate + (size_t)ct * 128 * 1024, 1024, 1024, gate, smem, ss);
#pragma unroll
      for (int i = 0; i < 4; ++i) { float v = ss[i]; v += shx<1>(v); v += shx<2>(v); v += shx<4>(v); if ((tid & 7) == 0) rowstat[(tid >> 3) + 32 * i] = rsqrtf(v * (1.f / 1024.f) + EPS_); }
      __syncthreads();
      float rsr[16];
#pragma unroll
      for (int r = 0; r < 16; ++r) rsr[r] = rowstat[32 * w + (r & 3) + 8 * (r >> 2) + 4 * fh];
#pragma unroll
      for (int n = 0; n < 4; ++n)
#pragma unroll
        for (int r = 0; r < 8; ++r) { h2 hv; hv[0] = (_Float16)sigmoidf_(gate[n][2 * r] * rsr[2 * r]); hv[1] = (_Float16)sigmoidf_(gate[n][2 * r + 1] * rsr[2 * r + 1]); gp[n][r] = __builtin_bit_cast(unsigned, hv); }
    }
    f32x16 acc[4]; zero_acc<4>(acc);
    gemm_mainloop_f32a<false>(pp + (size_t)rt * 128 * 256, 256, P.wt_pe + (size_t)ct * 128 * 256, 256, 256, acc, smem, ss);
#pragma unroll
    for (int n = 0; n < 4; ++n)
#pragma unroll
      for (int r = 0; r < 16; ++r) { const h2 gv = __builtin_bit_cast(h2, gp[n][r >> 1]); acc[n][r] *= (float)gv[r & 1]; }
    stage_f32(acc, (float*)smem);
    const size_t org = (size_t)(rt * 128) * 1024 + ct * 128;
    residual_out((const float*)smem, (const float*)P.z + org, P.out + org);
  }
}

__shared__ __attribute__((aligned(16))) unsigned char g_smem[SMEM_BYTES];
__shared__ Params g_P;
template <class Tp> DEVI Tp* uni(Tp* p) {
  const unsigned long long v = (unsigned long long)p;
  const unsigned lo = __builtin_amdgcn_readfirstlane((unsigned)v), hi = __builtin_amdgcn_readfirstlane((unsigned)(v >> 32));
  typedef __attribute__((address_space(1))) Tp* gptr_t;
  return (Tp*)(gptr_t)(((unsigned long long)hi << 32) | lo);
}
DEVI Params get_params() {
  Params P;
  P.x = uni(g_P.x);
  P.p = uni(g_P.p);
  P.pos = uni(g_P.pos);
  P.norm_g = uni(g_P.norm_g);
  P.ab_w_in = uni(g_P.ab_w_in);
  P.mla_q_norm = uni(g_P.mla_q_norm);
  P.mla_w_uq = uni(g_P.mla_w_uq);
  P.mla_kv_norm = uni(g_P.mla_kv_norm);
  P.mla_w_ukv = uni(g_P.mla_w_ukv);
  P.mla_q_gain = uni(g_P.mla_q_gain);
  P.mla_k_gain = uni(g_P.mla_k_gain);
  P.chk_q_gain = uni(g_P.chk_q_gain);
  P.chk_k_gain = uni(g_P.chk_k_gain);
  P.chk_rel_bias = uni(g_P.chk_rel_bias);
  P.ab_w_out = uni(g_P.ab_w_out);
  P.fox_w_in = uni(g_P.fox_w_in);
  P.fox_b_f = uni(g_P.fox_b_f);
  P.fox_q_gain = uni(g_P.fox_q_gain);
  P.fox_k_gain = uni(g_P.fox_k_gain);
  P.fox_w_out = uni(g_P.fox_w_out);
  P.pe_w = uni(g_P.pe_w);
  P.pe_gate_norm = uni(g_P.pe_gate_norm);
  P.pe_gate_w = uni(g_P.pe_gate_w);
  P.out = uni(g_P.out);
  P.wt_in = uni(g_P.wt_in);
  P.wt_uq = uni(g_P.wt_uq);
  P.wt_ukv = uni(g_P.wt_ukv);
  P.wt_out = uni(g_P.wt_out);
  P.wt_pe = uni(g_P.wt_pe);
  P.wt_gate = uni(g_P.wt_gate);
  P.cosT = uni(g_P.cosT);
  P.sinT = uni(g_P.sinT);
  P.uy = uni(g_P.uy);
  P.pb = uni(g_P.pb);
  P.z = uni(g_P.z);
  P.qm = uni(g_P.qm);
  P.km = uni(g_P.km);
  P.vtm = uni(g_P.vtm);
  P.vt = uni(g_P.vt);
  P.logf = uni(g_P.logf);
  P.cum = uni(g_P.cum);
  P.bar = uni(g_P.bar);
  return P;
}
#define NOINL DEVI
NOINL void ph_prep(int layer) { const Params P = get_params(); phase_prep(P, layer, g_smem); }
NOINL void ph_in_even(int l) { const Params P = get_params(); phase_in_even(P, l, g_smem); }
NOINL void ph_in_odd(int l) { const Params P = get_params(); phase_in_odd(P, l, g_smem); }
NOINL void ph_mla_up(int l) { const Params P = get_params(); phase_mla_up(P, l, g_smem); }
NOINL void ph_scan() { const Params P = get_params(); phase_scan(P, g_smem); }
NOINL void ph_attn_even(int l) { const Params P = get_params(); phase_attn_even(P, l, g_smem); }
NOINL void ph_attn_odd(int l) { const Params P = get_params(); phase_attn_odd(P, l, g_smem); }
NOINL void ph_outproj(int layer) { const Params P = get_params(); phase_outproj(P, layer, g_smem); }
NOINL void ph_norm2(int layer) { const Params P = get_params(); phase_norm2(P, layer); }
NOINL void ph_ple(int layer) { const Params P = get_params(); phase_ple(P, layer, g_smem); }

#define XB_TMO      128
#define XB_XCNT(j)  (256  + 64 * (j))
#define XB_XSUB(j)  (1280 + 64 * (j))
#define XB_XGEN(j)  (2304 + 64 * (j))
#define XB_TOP      3328
#define XB_TOPGEN   3392
#define XCD_BAR_WORDS 3456
#define XB_SPIN_CAP (1u << 18)
#define LAS __attribute__((address_space(3)))
DEVI unsigned xb_ld(unsigned* p) { return __hip_atomic_load(p, __ATOMIC_RELAXED, __HIP_MEMORY_SCOPE_AGENT); }
DEVI unsigned xb_add(unsigned* p, unsigned v) { return __hip_atomic_fetch_add(p, v, __ATOMIC_RELAXED, __HIP_MEMORY_SCOPE_AGENT); }
DEVI unsigned xb_xcc_id() { return (unsigned)__builtin_amdgcn_s_getreg((3 << 11) | 20) & 0xFu; }
#define XB_SPIN(cond, bar) do { unsigned _sp = 0; while (cond) { __builtin_amdgcn_s_sleep(1); \
    if ((++_sp & 255u) == 0u) { if (xb_ld(&(bar)[XB_TMO])) break; if (_sp > XB_SPIN_CAP) { atomicAdd(&(bar)[XB_TMO], 1u); break; } } } } while (0)
struct XcdBarrier { unsigned* bar; unsigned x; volatile LAS unsigned* st; };
DEVI void xcd_barrier_complete(unsigned* bar, unsigned x, unsigned& nloc, unsigned& nx);
DEVI XcdBarrier xcd_barrier_post(unsigned* bar, volatile LAS unsigned* st) {
  XcdBarrier b; b.bar = bar; b.x = xb_xcc_id(); b.st = st;
  if (tid_() == 0) {
    const unsigned lid = xb_add(&bar[XB_XCNT(b.x)], 1u);
    unsigned nloc, nx; xcd_barrier_complete(bar, b.x, nloc, nx);
    unsigned rank = 0;
    for (unsigned j = 0; j < 16; ++j) { if (j < b.x && xb_ld(&bar[XB_XCNT(j)]) > 0u) ++rank; }
    st[0] = nloc; st[1] = nx; st[2] = lid; st[3] = rank;
  }
  __syncthreads();
  return b;
}
DEVI void xcd_barrier_complete(unsigned* bar, unsigned x, unsigned& nloc, unsigned& nx) {
  const unsigned G = gridDim.x * gridDim.y * gridDim.z;
  unsigned sum, cnt, mine, sp = 0u;
  for (;;) {
    sum = 0u; cnt = 0u; mine = 0u;
#pragma unroll
    for (unsigned j = 0; j < 16; ++j) { const unsigned c = xb_ld(&bar[XB_XCNT(j)]); sum += c; cnt += (c > 0u) ? 1u : 0u; mine = (j == x) ? c : mine; }
    if (sum == G) break;
    __builtin_amdgcn_s_sleep(1);
    if ((++sp & 255u) == 0u) { if (xb_ld(&bar[XB_TMO])) break; if (sp > XB_SPIN_CAP) { atomicAdd(&bar[XB_TMO], 1u); break; } }
  }
  nloc = mine > 0u ? mine : 1u; nx = cnt > 0u ? cnt : 1u;
}
DEVI void xcd_barrier(const XcdBarrier& b) {
  asm volatile("s_waitcnt vmcnt(0)" ::: "memory");
  __syncthreads();
  if (tid_() == 0) {
    unsigned* bar = b.bar;
    __builtin_amdgcn_s_waitcnt(0);
    unsigned nloc = b.st[0], nx = b.st[1];
    if (nloc == 0u) { xcd_barrier_complete(bar, b.x, nloc, nx); b.st[0] = nloc; b.st[1] = nx; }
    const unsigned old = xb_add(&bar[XB_XSUB(b.x)], 1u);
    const unsigned gen = old / nloc;
    if (old + 1u == (gen + 1u) * nloc) {
      __builtin_amdgcn_fence(__ATOMIC_RELEASE, "agent");
      asm volatile("s_waitcnt vmcnt(0)" ::: "memory");
      const unsigned og = xb_add(&bar[XB_TOP], 1u);
      const unsigned tg = og / nx;
      if (og + 1u == (tg + 1u) * nx) xb_add(&bar[XB_TOPGEN], 1u);
      else XB_SPIN(xb_ld(&bar[XB_TOPGEN]) == tg, bar);
      __builtin_amdgcn_fence(__ATOMIC_ACQUIRE, "agent");
      xb_add(&bar[XB_XGEN(b.x)], 1u);
      asm volatile("s_waitcnt vmcnt(0)" ::: "memory");
    } else {
      XB_SPIN(xb_ld(&bar[XB_XGEN(b.x)]) == gen, bar);
      __builtin_amdgcn_fence(__ATOMIC_ACQUIRE, "agent");
      asm volatile("s_waitcnt vmcnt(0)" ::: "memory");
    }
  }
  __syncthreads();
}

template <bool COOP>
__global__ void __launch_bounds__(256, 2) mega(Params Pk, int ph_begin, int ph_end) {
  if (tid_() == 0) g_P = Pk;
  if (tid_() == 0) g_xb = make_uint4(0u, 0u, 0u, 0u);
  if (COOP && blockIdx.x == 0) { for (int i = tid_(); i < XCD_BAR_WORDS; i += 256) __hip_atomic_store(Pk.bar + i, 0u, __ATOMIC_RELAXED, __HIP_MEMORY_SCOPE_AGENT); }
  __syncthreads();
  XcdBarrier xb; xb.bar = Pk.bar; xb.x = 0; xb.st = (volatile LAS unsigned*)&g_xb;
  if (COOP) { cg::this_grid().sync(); xb = xcd_barrier_post(Pk.bar, (volatile LAS unsigned*)&g_xb); }
  for (int ph = ph_begin; ph < ph_end; ++ph) {
    const int layer = ph / 6, j = ph % 6, l = layer >> 1;
    const bool even = (layer & 1) == 0;
#ifdef PROBE_MASK
    for (int rep_ = 0; rep_ < ((((PROBE_MASK) >> j) & 1) ? 2 : 1); ++rep_)
#endif
    switch (j) {
      case 0: ph_prep(layer); break;
      case 1: if (even) ph_in_even(l); else ph_in_odd(l); break;
      case 2: if (even) ph_mla_up(l); else ph_scan(); break;
      case 3: if (even) ph_attn_even(l); else ph_attn_odd(l); break;
      case 4: ph_outproj(layer); break;
      default: ph_ple(layer); break;
    }
    if (COOP && ph + 1 < ph_end) {
      xcd_barrier(xb);
    }
  }
}

extern "C" void kernel_launch(void* const* d_in, const int* in_sizes, int n_in, void* d_out, int out_size, void* d_ws, size_t ws_size, hipStream_t stream) {
  Params P{};
  P.x = (const float*)d_in[0]; P.p = (const float*)d_in[1]; P.pos = (const int*)d_in[2];
  P.norm_g = (const float*)d_in[3]; P.ab_w_in = (const float*)d_in[4]; P.mla_q_norm = (const float*)d_in[5]; P.mla_w_uq = (const float*)d_in[6];
  P.mla_kv_norm = (const float*)d_in[7]; P.mla_w_ukv = (const float*)d_in[8]; P.mla_q_gain = (const float*)d_in[9]; P.mla_k_gain = (const float*)d_in[10];
  P.chk_q_gain = (const float*)d_in[11]; P.chk_k_gain = (const float*)d_in[12]; P.chk_rel_bias = (const float*)d_in[13]; P.ab_w_out = (const float*)d_in[14];
  P.fox_w_in = (const float*)d_in[15]; P.fox_b_f = (const float*)d_in[16]; P.fox_q_gain = (const float*)d_in[17]; P.fox_k_gain = (const float*)d_in[18];
  P.fox_w_out = (const float*)d_in[19]; P.pe_w = (const float*)d_in[20]; P.pe_gate_norm = (const float*)d_in[21]; P.pe_gate_w = (const float*)d_in[22];
  P.out = (float*)d_out;
  unsigned char* wsp = (unsigned char*)d_ws; size_t off = 0;
  auto take = [&](size_t bytes) { unsigned char* r = wsp + off; off += (bytes + 255) & ~(size_t)255; return r; };
  P.wt_in = (bf16_t*)take((size_t)4224 * 1024 * 2); P.wt_uq = (bf16_t*)take((size_t)768 * 384 * 2); P.wt_ukv = (bf16_t*)take((size_t)1024 * 256 * 2);
  P.wt_out = (bf16_t*)take((size_t)1024 * 1024 * 2); P.wt_pe = (bf16_t*)take((size_t)1024 * 256 * 2); P.wt_gate = (bf16_t*)take((size_t)1024 * 1024 * 2);
  P.cosT = (float*)take((size_t)T_ * 16 * 4); P.sinT = (float*)take((size_t)T_ * 16 * 4);
  P.uy = (bf16_t*)take((size_t)T_ * 1024 * 2); P.pb = (bf16_t*)take((size_t)T_ * 256 * 2);
  P.z = (bf16_t*)take((size_t)T_ * ZO * 2);
  P.qm = (bf16_t*)take((size_t)T_ * 8 * 96 * 2); P.km = (bf16_t*)take((size_t)T_ * 8 * 96 * 2); P.vtm = (bf16_t*)take((size_t)T_ * 8 * 64 * 2);
  P.vt = (bf16_t*)take((size_t)T_ * 16 * 64 * 2);
  P.logf = (float*)take((size_t)T_ * 16 * 4); P.cum = (float*)take((size_t)T_ * 16 * 4);
  P.bar = (unsigned*)take((size_t)XCD_BAR_WORDS * 4);
  if (off > ws_size) { fprintf(stderr, "workspace too small: need %zu have %zu\n", off, ws_size); }
#if USE_COOP
  static int grid_blocks = 0;
  if (!grid_blocks) {
    int dev = 0, cus = 0, per_cu = 0;
    hipGetDevice(&dev);
    hipDeviceGetAttribute(&cus, hipDeviceAttributeMultiprocessorCount, dev);
    hipOccupancyMaxActiveBlocksPerMultiprocessor(&per_cu, mega<true>, 256, 0);
    if (per_cu > 2) per_cu = 2;
    if (per_cu < 1) per_cu = 1;
    grid_blocks = cus * per_cu;
  }
  int pb = 0, pe = NPH;
  void* args[] = {&P, &pb, &pe};
  hipError_t e = hipLaunchCooperativeKernel((void*)mega<true>, dim3(grid_blocks), dim3(256), args, 0, stream);
  if (e != hipSuccess) fprintf(stderr, "cooperative launch failed: %s (grid %d)\n", hipGetErrorString(e), grid_blocks);
#else
  for (int ph = 0; ph < NPH; ++ph) mega<false><<<512, 256, 0, stream>>>(P, ph, ph + 1);
#endif
}
```

```cpp
#include <hip/hip_runtime.h>
#include <hip/hip_cooperative_groups.h>
#include <cstdio>
#include <cstdint>
namespace cg = cooperative_groups;

#ifndef USE_COOP
#define USE_COOP 1
#endif

#define DEVI __device__ __forceinline__
#define FENCE() do { asm volatile("" ::: "memory"); __builtin_amdgcn_sched_barrier(0); } while (0)
typedef unsigned short bf16_t;
typedef short bf16x8 __attribute__((ext_vector_type(8)));
typedef float f32x16 __attribute__((ext_vector_type(16)));
typedef float f32x4 __attribute__((ext_vector_type(4)));
typedef unsigned u32x4 __attribute__((ext_vector_type(4)));

constexpr int S_ = 8192, T_ = 16384;
constexpr float EPS_ = 1e-6f, LOG2E_ = 1.4426950408889634f;
constexpr int ZE = 2720, ZO = 3072;
constexpr int LDT = 72;
constexpr int SMEM_BYTES = 2 * 128 * LDT * 2 * 2 + 512;
constexpr int NPH = 24;

struct Params {
  const float* x; const float* p; const int* pos;
  const float* norm_g; const float* ab_w_in; const float* mla_q_norm; const float* mla_w_uq; const float* mla_kv_norm; const float* mla_w_ukv;
  const float* mla_q_gain; const float* mla_k_gain; const float* chk_q_gain; const float* chk_k_gain; const float* chk_rel_bias; const float* ab_w_out;
  const float* fox_w_in; const float* fox_b_f; const float* fox_q_gain; const float* fox_k_gain; const float* fox_w_out;
  const float* pe_w; const float* pe_gate_norm; const float* pe_gate_w;
  float* out;
  bf16_t* wt_in; bf16_t* wt_uq; bf16_t* wt_ukv; bf16_t* wt_out; bf16_t* wt_pe; bf16_t* wt_gate;
  float* cosT; float* sinT;
  bf16_t* uy; bf16_t* pb; bf16_t* z;
  bf16_t* qm; bf16_t* km; bf16_t* vtm; bf16_t* vt;
  float* logf; float* cum;
  unsigned* bar;
};

DEVI int tid_() { int t = __builtin_amdgcn_workitem_id_x(); asm volatile("" : "+v"(t)); return t; }
DEVI unsigned cvt_pk_bf16(float lo, float hi) { unsigned r; asm("v_cvt_pk_bf16_f32 %0, %1, %2" : "=v"(r) : "v"(lo), "v"(hi)); return r; }
DEVI float bf2f(bf16_t v) { return __uint_as_float(((unsigned)v) << 16); }
DEVI bf16_t f2bf(float f) { return (bf16_t)(cvt_pk_bf16(f, 0.f) & 0xffffu); }
DEVI float sigmoidf_(float x) { return __builtin_amdgcn_rcpf(1.f + __expf(-x)); }
DEVI float siluf_(float x) { return x * sigmoidf_(x); }
template <int M> DEVI float shx(float v) {
  if constexpr (M < 32) return __int_as_float(__builtin_amdgcn_ds_swizzle(__float_as_int(v), (M << 10) | 0x1f));
  else return __int_as_float(__builtin_amdgcn_ds_bpermute(((tid_() & 63) ^ 32) << 2, __float_as_int(v)));
}
DEVI float hsum32(float v) { v += shx<1>(v); v += shx<2>(v); v += shx<4>(v); v += shx<8>(v); v += shx<16>(v); return v; }
DEVI float sq2(unsigned u) { const float lo = __uint_as_float(u << 16), hi = __uint_as_float(u & 0xffff0000u); return lo * lo + hi * hi; }
DEVI int vbid() { const int G = gridDim.x, b = blockIdx.x; return ((G & 7) == 0) ? (b & 7) * (G >> 3) + (b >> 3) : b; }


__shared__ uint4 g_xb;
struct TileIter { int c, tl, nloc, nx, lid, ntiles, nct, nrt; };
DEVI void decode_item(int t, int nct, int nrt, int& rt, int& ct) {
  const int ng = nct >> 3, gs = nrt * 8;
  if (t < ng * gs) { const int g = t / gs, rem = t - g * gs; rt = rem >> 3; ct = g * 8 + (rem & 7); }
  else { const int wl = nct - 8 * ng, t2 = t - ng * gs; rt = t2 / wl; ct = 8 * ng + t2 % wl; }
}
DEVI void tile_begin(TileIter& ti, int nct, int nrt = 128, int nitems = -1) {
  const uint4 cx = g_xb;
  ti.nct = nct; ti.nrt = nrt; ti.ntiles = nitems < 0 ? nrt * nct : nitems;
  if (cx.x == 0u) { ti.lid = blockIdx.x; ti.c = 0; ti.tl = blockIdx.x; ti.nloc = gridDim.x; ti.nx = 0; return; }
  ti.nloc = (int)cx.x; ti.nx = (int)cx.y; ti.lid = (int)cx.z; ti.c = (int)cx.w; ti.tl = ti.lid;
}
DEVI bool tile_next(TileIter& ti, int& rt, int& ct) {
  int t;
  if (ti.nx == 0) { t = ti.tl; ti.tl += ti.nloc; if (t >= ti.ntiles) return false; }
  else {
    for (;;) {
      if (ti.c * 64 >= ti.ntiles) return false;
      if (ti.tl < 64) { t = ti.c * 64 + ti.tl; ti.tl += ti.nloc; if (t < ti.ntiles) break; continue; }
      ti.c += ti.nx; ti.tl = ti.lid;
    }
  }
  decode_item(t, ti.nct, ti.nrt, rt, ct);
  return true;
}

template <int BN, bool ROWSS, bool DEEP = true>
DEVI void gemm_mainloop(const bf16_t* __restrict__ A, int lda, const bf16_t* __restrict__ Bt, int ldb, int K,
                        f32x16 (&acc)[BN / 32], unsigned char* smem, f32x4& ss) {
  constexpr int TN = BN / 32;
  bf16_t* As = (bf16_t*)smem;
  bf16_t* Bs = As + 2 * 128 * LDT;
  const int tid = tid_(), lane = tid & 63, w = tid >> 6;
  const int lr = tid >> 3, kc = tid & 7;
  const bf16_t* ap = A + (size_t)lr * lda + kc * 8;
  const bf16_t* bp = Bt + (size_t)lr * ldb + kc * 8;
  const size_t sa = (size_t)32 * lda, sb = (size_t)32 * ldb;
  uint4 pa0, pa1, pa2, pa3, pb0, pb1, pb2, pb3, qa0, qa1, qa2, qa3, qb0, qb1, qb2, qb3;
#define GL_(X, ko) do { X##a0 = *(const uint4*)(ap + (ko)); X##a1 = *(const uint4*)(ap + sa + (ko)); X##a2 = *(const uint4*)(ap + 2 * sa + (ko)); X##a3 = *(const uint4*)(ap + 3 * sa + (ko)); \
    X##b0 = *(const uint4*)(bp + (ko)); if (TN > 1) X##b1 = *(const uint4*)(bp + sb + (ko)); if (TN > 2) X##b2 = *(const uint4*)(bp + 2 * sb + (ko)); if (TN > 3) X##b3 = *(const uint4*)(bp + 3 * sb + (ko)); } while (0)
#define SSQ_(v) (sq2((v).x) + sq2((v).y) + sq2((v).z) + sq2((v).w))
#define ST_(X, buf) do { bf16_t* a_ = As + (buf) * 128 * LDT + wr_off; bf16_t* b_ = Bs + (buf) * 128 * LDT + wr_off; \
    *(uint4*)(a_) = X##a0; *(uint4*)(a_ + 32 * LDT) = X##a1; *(uint4*)(a_ + 64 * LDT) = X##a2; *(uint4*)(a_ + 96 * LDT) = X##a3; \
    *(uint4*)(b_) = X##b0; if (TN > 1) *(uint4*)(b_ + 32 * LDT) = X##b1; if (TN > 2) *(uint4*)(b_ + 64 * LDT) = X##b2; if (TN > 3) *(uint4*)(b_ + 96 * LDT) = X##b3; \
    if (ROWSS) { ss[0] += SSQ_(X##a0); ss[1] += SSQ_(X##a1); ss[2] += SSQ_(X##a2); ss[3] += SSQ_(X##a3); } } while (0)
#define LDF_(S, Ac, Bc, ks) do { S##a = *(const bf16x8*)((Ac) + 16 * (ks)); S##b0 = *(const bf16x8*)((Bc) + 16 * (ks)); if (TN > 1) S##b1 = *(const bf16x8*)((Bc) + 32 * LDT + 16 * (ks)); \
    if (TN > 2) S##b2 = *(const bf16x8*)((Bc) + 64 * LDT + 16 * (ks)); if (TN > 3) S##b3 = *(const bf16x8*)((Bc) + 96 * LDT + 16 * (ks)); } while (0)
#define MF_(S) do { __builtin_amdgcn_s_setprio(1); acc[0] = __builtin_amdgcn_mfma_f32_32x32x16_bf16(S##a, S##b0, acc[0], 0, 0, 0); if (TN > 1) acc[TN > 1 ? 1 : 0] = __builtin_amdgcn_mfma_f32_32x32x16_bf16(S##a, S##b1, acc[TN > 1 ? 1 : 0], 0, 0, 0); \
    if (TN > 2) acc[TN > 2 ? 2 : 0] = __builtin_amdgcn_mfma_f32_32x32x16_bf16(S##a, S##b2, acc[TN > 2 ? 2 : 0], 0, 0, 0); if (TN > 3) acc[TN - 1] = __builtin_amdgcn_mfma_f32_32x32x16_bf16(S##a, S##b3, acc[TN - 1], 0, 0, 0); __builtin_amdgcn_s_setprio(0); } while (0)
#define MMA_(buf) do { const bf16_t* Ac = As + (buf) * 128 * LDT + a_rd; const bf16_t* Bc = Bs + (buf) * 128 * LDT + b_rd; \
    LDF_(fx, Ac, Bc, 0); __builtin_amdgcn_sched_barrier(0); \
    LDF_(fy, Ac, Bc, 1); __builtin_amdgcn_sched_barrier(0); MF_(fx); __builtin_amdgcn_sched_barrier(0); \
    LDF_(fx, Ac, Bc, 2); __builtin_amdgcn_sched_barrier(0); MF_(fy); __builtin_amdgcn_sched_barrier(0); \
    LDF_(fy, Ac, Bc, 3); __builtin_amdgcn_sched_barrier(0); MF_(fx); __builtin_amdgcn_sched_barrier(0); \
    MF_(fy); __builtin_amdgcn_sched_barrier(0); } while (0)
  bf16x8 fxa, fxb0, fxb1, fxb2, fxb3, fya, fyb0, fyb1, fyb2, fyb3;
  pb3 = make_uint4(0, 0, 0, 0); qb3 = pb3; pb2 = pb3; qb2 = pb3; pb1 = pb3; qb1 = pb3;
  GL_(p, 0);
  const int nk = K >> 6;
  const int fr = lane & 31, fh = lane >> 5;
  const int a_rd = (32 * w + fr) * LDT + 8 * fh;
  const int b_rd = fr * LDT + 8 * fh;
  const int wr_off = lr * LDT + kc * 8;
  if (ROWSS) { ss[0] = 0.f; ss[1] = 0.f; ss[2] = 0.f; ss[3] = 0.f; }
  if constexpr (!DEEP) {
    ST_(p, 0);
    __syncthreads();
#pragma unroll 1
    for (int kt = 0; kt < nk; kt += 2) {
      GL_(p, (kt + 1) * 64);
      MMA_(0);
      ST_(p, 1);
      __syncthreads();
      if (kt + 2 < nk) GL_(p, (kt + 2) * 64);
      MMA_(1);
      if (kt + 2 < nk) ST_(p, 0);
      __syncthreads();
    }
    return;
  }
  GL_(q, 64);
  ST_(p, 0);
  __syncthreads();
#pragma unroll 1
  for (int kt = 0; kt < nk; kt += 2) {
    if (kt + 2 < nk) GL_(p, (kt + 2) * 64);
    MMA_(0);
    ST_(q, 1);
    __syncthreads();
    if (kt + 3 < nk) GL_(q, (kt + 3) * 64);
    MMA_(1);
    if (kt + 2 < nk) ST_(p, 0);
    __syncthreads();
  }
#undef GL_
#undef ST_
#undef MMA_
#undef LDF_
#undef MF_
}

template <bool ROWSS>
DEVI void gemm_mainloop_f32a(const float* __restrict__ A, int lda, const bf16_t* __restrict__ Bt, int ldb, int K,
                             f32x16 (&acc)[4], unsigned char* smem, f32x4& ss) {
  constexpr int TN = 4;
  bf16_t* As = (bf16_t*)smem;
  bf16_t* Bs = As + 2 * 128 * LDT;
  const int tid = tid_(), lane = tid & 63, w = tid >> 6;
  const int lr = tid >> 3, kc = tid & 7;
  const float* ap = A + (size_t)lr * lda + kc * 8;
  const bf16_t* bp = Bt + (size_t)lr * ldb + kc * 8;
  const size_t sa = (size_t)32 * lda, sb = (size_t)32 * ldb;
  f32x4 a0l, a0h, a1l, a1h, a2l, a2h, a3l, a3h; uint4 rb0, rb1, rb2, rb3;
#define GLF_(ko) do { a0l = *(const f32x4*)(ap + (ko)); a0h = *(const f32x4*)(ap + (ko) + 4); a1l = *(const f32x4*)(ap + sa + (ko)); a1h = *(const f32x4*)(ap + sa + (ko) + 4); \
    a2l = *(const f32x4*)(ap + 2 * sa + (ko)); a2h = *(const f32x4*)(ap + 2 * sa + (ko) + 4); a3l = *(const f32x4*)(ap + 3 * sa + (ko)); a3h = *(const f32x4*)(ap + 3 * sa + (ko) + 4); \
    rb0 = *(const uint4*)(bp + (ko)); rb1 = *(const uint4*)(bp + sb + (ko)); rb2 = *(const uint4*)(bp + 2 * sb + (ko)); rb3 = *(const uint4*)(bp + 3 * sb + (ko)); } while (0)
#define CVT8_(l, h) make_uint4(cvt_pk_bf16((l)[0], (l)[1]), cvt_pk_bf16((l)[2], (l)[3]), cvt_pk_bf16((h)[0], (h)[1]), cvt_pk_bf16((h)[2], (h)[3]))
#define SQ8_(l, h) ((l)[0] * (l)[0] + (l)[1] * (l)[1] + (l)[2] * (l)[2] + (l)[3] * (l)[3] + (h)[0] * (h)[0] + (h)[1] * (h)[1] + (h)[2] * (h)[2] + (h)[3] * (h)[3])
#define STF_(buf) do { bf16_t* a_ = As + (buf) * 128 * LDT + wr_off; bf16_t* b_ = Bs + (buf) * 128 * LDT + wr_off; \
    *(uint4*)(a_) = CVT8_(a0l, a0h); *(uint4*)(a_ + 32 * LDT) = CVT8_(a1l, a1h); *(uint4*)(a_ + 64 * LDT) = CVT8_(a2l, a2h); *(uint4*)(a_ + 96 * LDT) = CVT8_(a3l, a3h); \
    *(uint4*)(b_) = rb0; *(uint4*)(b_ + 32 * LDT) = rb1; *(uint4*)(b_ + 64 * LDT) = rb2; *(uint4*)(b_ + 96 * LDT) = rb3; \
    if (ROWSS) { ss[0] += SQ8_(a0l, a0h); ss[1] += SQ8_(a1l, a1h); ss[2] += SQ8_(a2l, a2h); ss[3] += SQ8_(a3l, a3h); } } while (0)
#define LDF_(S, Ac, Bc, ks) do { S##a = *(const bf16x8*)((Ac) + 16 * (ks)); S##b0 = *(const bf16x8*)((Bc) + 16 * (ks)); S##b1 = *(const bf16x8*)((Bc) + 32 * LDT + 16 * (ks)); \
    S##b2 = *(const bf16x8*)((Bc) + 64 * LDT + 16 * (ks)); S##b3 = *(const bf16x8*)((Bc) + 96 * LDT + 16 * (ks)); } while (0)
#define MF_(S) do { acc[0] = __builtin_amdgcn_mfma_f32_32x32x16_bf16(S##a, S##b0, acc[0], 0, 0, 0); acc[1] = __builtin_amdgcn_mfma_f32_32x32x16_bf16(S##a, S##b1, acc[1], 0, 0, 0); \
    acc[2] = __builtin_amdgcn_mfma_f32_32x32x16_bf16(S##a, S##b2, acc[2], 0, 0, 0); acc[3] = __builtin_amdgcn_mfma_f32_32x32x16_bf16(S##a, S##b3, acc[3], 0, 0, 0); } while (0)
#define MMA_(buf) do { const bf16_t* Ac = As + (buf) * 128 * LDT + a_rd; const bf16_t* Bc = Bs + (buf) * 128 * LDT + b_rd; \
    LDF_(fx, Ac, Bc, 0); __builtin_amdgcn_sched_barrier(0); \
    LDF_(fy, Ac, Bc, 1); __builtin_amdgcn_sched_barrier(0); MF_(fx); __builtin_amdgcn_sched_barrier(0); \
    LDF_(fx, Ac, Bc, 2); __builtin_amdgcn_sched_barrier(0); MF_(fy); __builtin_amdgcn_sched_barrier(0); \
    LDF_(fy, Ac, Bc, 3); __builtin_amdgcn_sched_barrier(0); MF_(fx); __builtin_amdgcn_sched_barrier(0); \
    MF_(fy); __builtin_amdgcn_sched_barrier(0); } while (0)
  bf16x8 fxa, fxb0, fxb1, fxb2, fxb3, fya, fyb0, fyb1, fyb2, fyb3;
  GLF_(0);
  const int nk = K >> 6;
  const int fr = lane & 31, fh = lane >> 5;
  const int a_rd = (32 * w + fr) * LDT + 8 * fh;
  const int b_rd = fr * LDT + 8 * fh;
  const int wr_off = lr * LDT + kc * 8;
  if (ROWSS) { ss[0] = 0.f; ss[1] = 0.f; ss[2] = 0.f; ss[3] = 0.f; }
  STF_(0);
  __syncthreads();
#pragma unroll 1
  for (int kt = 0; kt < nk; kt += 2) {
    GLF_((kt + 1) * 64);
    MMA_(0);
    STF_(1);
    __syncthreads();
    if (kt + 2 < nk) GLF_((kt + 2) * 64);
    MMA_(1);
    if (kt + 2 < nk) STF_(0);
    __syncthreads();
  }
#undef GLF_
#undef STF_
#undef MMA_
#undef LDF_
#undef MF_
}

constexpr int LD2 = 40;
DEVI void gemm_mainloop2(const bf16_t* __restrict__ A0, const bf16_t* __restrict__ A1, int lda, const bf16_t* __restrict__ Bt, int ldb, int K,
                         f32x16 (&acc0)[4], f32x16 (&acc1)[4], unsigned char* smem) {
  bf16_t* L = (bf16_t*)smem;
  constexpr int STG = 384 * LD2;
  const int tid = tid_(), lane = tid & 63, w = tid >> 6;
  const int lr = tid >> 2, kc = tid & 3;
  const bf16_t* a0p = A0 + (size_t)lr * lda + kc * 8;
  const bf16_t* a1p = A1 + (size_t)lr * lda + kc * 8;
  const bf16_t* bp = Bt + (size_t)lr * ldb + kc * 8;
  const size_t sa = (size_t)64 * lda, sb = (size_t)64 * ldb;
  uint4 pa0, pa1, pc0, pc1, pb0, pb1, qa0, qa1, qc0, qc1, qb0, qb1;
#define GL2_(X, ko) do { X##a0 = *(const uint4*)(a0p + (ko)); X##a1 = *(const uint4*)(a0p + sa + (ko)); X##c0 = *(const uint4*)(a1p + (ko)); X##c1 = *(const uint4*)(a1p + sa + (ko)); \
    X##b0 = *(const uint4*)(bp + (ko)); X##b1 = *(const uint4*)(bp + sb + (ko)); } while (0)
#define ST2_(X, buf) do { bf16_t* d_ = L + (buf) * STG + wr_off; *(uint4*)(d_) = X##a0; *(uint4*)(d_ + 64 * LD2) = X##a1; *(uint4*)(d_ + 128 * LD2) = X##c0; *(uint4*)(d_ + 192 * LD2) = X##c1; \
    *(uint4*)(d_ + 256 * LD2) = X##b0; *(uint4*)(d_ + 320 * LD2) = X##b1; } while (0)
#define LF2_(S, ks) do { S##a0 = *(const bf16x8*)(Lc + 16 * (ks)); S##a1 = *(const bf16x8*)(Lc + 128 * LD2 + 16 * (ks)); \
      S##b0 = *(const bf16x8*)(Lc + rdb + 16 * (ks)); S##b1 = *(const bf16x8*)(Lc + rdb + 32 * LD2 + 16 * (ks)); S##b2 = *(const bf16x8*)(Lc + rdb + 64 * LD2 + 16 * (ks)); S##b3 = *(const bf16x8*)(Lc + rdb + 96 * LD2 + 16 * (ks)); } while (0)
#define MF2_(S) do { __builtin_amdgcn_s_setprio(1); \
      acc0[0] = __builtin_amdgcn_mfma_f32_32x32x16_bf16(S##a0, S##b0, acc0[0], 0, 0, 0); acc1[0] = __builtin_amdgcn_mfma_f32_32x32x16_bf16(S##a1, S##b0, acc1[0], 0, 0, 0); \
      acc0[1] = __builtin_amdgcn_mfma_f32_32x32x16_bf16(S##a0, S##b1, acc0[1], 0, 0, 0); acc1[1] = __builtin_amdgcn_mfma_f32_32x32x16_bf16(S##a1, S##b1, acc1[1], 0, 0, 0); \
      acc0[2] = __builtin_amdgcn_mfma_f32_32x32x16_bf16(S##a0, S##b2, acc0[2], 0, 0, 0); acc1[2] = __builtin_amdgcn_mfma_f32_32x32x16_bf16(S##a1, S##b2, acc1[2], 0, 0, 0); \
      acc0[3] = __builtin_amdgcn_mfma_f32_32x32x16_bf16(S##a0, S##b3, acc0[3], 0, 0, 0); acc1[3] = __builtin_amdgcn_mfma_f32_32x32x16_bf16(S##a1, S##b3, acc1[3], 0, 0, 0); \
      __builtin_amdgcn_s_setprio(0); } while (0)
#define MMA2_(buf) do { const bf16_t* Lc = L + (buf) * STG + rd_off; \
    LF2_(fx, 0); __builtin_amdgcn_sched_barrier(0); LF2_(fy, 1); __builtin_amdgcn_sched_barrier(0); \
    MF2_(fx); __builtin_amdgcn_sched_barrier(0); MF2_(fy); __builtin_amdgcn_sched_barrier(0); } while (0)
  bf16x8 fxa0, fxa1, fxb0, fxb1, fxb2, fxb3, fya0, fya1, fyb0, fyb1, fyb2, fyb3;
  GL2_(p, 0);
  const int nk = K >> 5;
  const int fr = lane & 31, fh = lane >> 5;
  const int rd_off = (32 * w + fr) * LD2 + 8 * fh;
  const int rdb = (256 + fr - 32 * w - fr) * LD2;
  const int wr_off = lr * LD2 + kc * 8;
  GL2_(q, 32);
  ST2_(p, 0);
  __syncthreads();
#pragma unroll 1
  for (int kt = 0; kt < nk; kt += 2) {
    { const int ko = min(kt + 2, nk - 1) * 32; GL2_(p, ko); }
    MMA2_(0);
    ST2_(q, 1);
    __syncthreads();
    { const int ko = min(kt + 3, nk - 1) * 32; GL2_(q, ko); }
    MMA2_(1);
    if (kt + 2 < nk) ST2_(p, 0);
    __syncthreads();
  }
#undef GL2_
#undef ST2_
#undef MMA2_
#undef LF2_
#undef MF2_
}

template <int TN> DEVI void zero_acc(f32x16 (&acc)[TN]) {
#pragma unroll
  for (int n = 0; n < TN; ++n)
#pragma unroll
    for (int r = 0; r < 16; ++r) acc[n][r] = 0.f;
}

#define ROW_OF(r) (32 * w + ((r) & 3) + 8 * ((r) >> 2) + 4 * fh)

constexpr int OLD = 136;
constexpr int OLF = 132;
DEVI void epi_store(const f32x16 (&acc)[4], bf16_t* ot, bool act, int ncols_tiles) {
  const int lane = tid_() & 63, w = tid_() >> 6, fr = lane & 31, fh = lane >> 5;
  bf16_t* o = ot + (32 * w + 4 * fh) * OLD + fr;
#pragma unroll
  for (int n = 0; n < 4; ++n) {
    if (n < ncols_tiles) {
#pragma unroll
      for (int r = 0; r < 16; ++r) { float v = acc[n][r]; if (act) v = siluf_(v); o[((r & 3) + 8 * (r >> 2)) * OLD + 32 * n] = f2bf(v); }
    }
  }
}

DEVI void epi_qknorm(const f32x16 (&acc)[4], const float* __restrict__ gain, float scale, bf16_t* ot) {
  const int lane = tid_() & 63, w = tid_() >> 6, fr = lane & 31, fh = lane >> 5;
  const float g0 = gain[fr] * scale, g1 = gain[32 + fr] * scale;
  bf16_t* o = ot + (32 * w + 4 * fh) * OLD + fr;
#pragma unroll
  for (int hh = 0; hh < 2; ++hh) {
    float sq[16];
#pragma unroll
    for (int r = 0; r < 16; ++r) { const float v0 = acc[2 * hh][r], v1 = acc[2 * hh + 1][r]; sq[r] = v0 * v0 + v1 * v1; }
#pragma unroll
    for (int r = 0; r < 16; ++r) sq[r] += shx<1>(sq[r]);
#pragma unroll
    for (int r = 0; r < 16; ++r) sq[r] += shx<2>(sq[r]);
#pragma unroll
    for (int r = 0; r < 16; ++r) sq[r] += shx<4>(sq[r]);
#pragma unroll
    for (int r = 0; r < 16; ++r) sq[r] += shx<8>(sq[r]);
#pragma unroll
    for (int r = 0; r < 16; ++r) sq[r] += shx<16>(sq[r]);
#pragma unroll
    for (int r = 0; r < 16; ++r) {
      const float rs = rsqrtf(sq[r] * (1.f / 64.f) + EPS_);
      bf16_t* d = o + ((r & 3) + 8 * (r >> 2)) * OLD + 64 * hh;
      d[0] = f2bf(acc[2 * hh][r] * rs * g0); d[32] = f2bf(acc[2 * hh + 1][r] * rs * g1);
    }
  }
}

DEVI void epi_vt(const f32x16& a0, const f32x16& a1, bf16_t* ot, int dvbase) {
  const int lane = tid_() & 63, w = tid_() >> 6, fr = lane & 31, fh = lane >> 5;
#pragma unroll
  for (int g = 0; g < 4; ++g) {
    const int so = 32 * w + 8 * g + 4 * fh;
    uint2 v0, v1;
    v0.x = cvt_pk_bf16(a0[4 * g], a0[4 * g + 1]); v0.y = cvt_pk_bf16(a0[4 * g + 2], a0[4 * g + 3]);
    v1.x = cvt_pk_bf16(a1[4 * g], a1[4 * g + 1]); v1.y = cvt_pk_bf16(a1[4 * g + 2], a1[4 * g + 3]);
    *(uint2*)(ot + (dvbase + fr) * OLD + so) = v0;
    *(uint2*)(ot + (dvbase + 32 + fr) * OLD + so) = v1;
  }
}

template <int NCH> DEVI void copy_out(const bf16_t* ot, bf16_t* dst, size_t ld, int nrows) {
  __syncthreads();
  const int total = nrows * NCH;
  for (int id = tid_(); id < total; id += 256) { const int row = id / NCH, ch = id - row * NCH; *(uint4*)(dst + (size_t)row * ld + ch * 8) = *(const uint4*)(ot + row * OLD + ch * 8); }
  __syncthreads();
}

DEVI void stage_f32(const f32x16 (&v)[4], float* of) {
  const int lane = tid_() & 63, w = tid_() >> 6, fr = lane & 31, fh = lane >> 5;
  float* o = of + (32 * w + 4 * fh) * OLF + fr;
#pragma unroll
  for (int n = 0; n < 4; ++n)
#pragma unroll
    for (int r = 0; r < 16; ++r) o[((r & 3) + 8 * (r >> 2)) * OLF + 32 * n] = v[n][r];
}
DEVI void residual_out(const float* of, const float* hin, float* out  ) {
  __syncthreads();
  const int tid = tid_();
#pragma unroll
  for (int half = 0; half < 2; ++half) {
    f32x4 hv[8];
#pragma unroll
    for (int i = 0; i < 8; ++i) { const int id = tid + 256 * (8 * half + i), row = id >> 5, ch = id & 31; hv[i] = *(const f32x4*)(hin + (size_t)row * 1024 + ch * 4); }
#pragma unroll
    for (int i = 0; i < 8; ++i) { const int id = tid + 256 * (8 * half + i), row = id >> 5, ch = id & 31;
      *(f32x4*)(out + (size_t)row * 1024 + ch * 4) = hv[i] + *(const f32x4*)(of + row * OLF + ch * 4); }
  }
  __syncthreads();
}

DEVI void transpose_tile(const float* __restrict__ src, int ldsrc, int nsrc_valid, int n_src0, int k0, const float* __restrict__ gain,
                         bf16_t* __restrict__ dst, int K, int n_dst0, unsigned char* smem) {
  bf16_t* tl = (bf16_t*)smem;
  const int tid = tid_();
  const int n = tid & 31, kk = tid >> 5;
#pragma unroll
  for (int j = 0; j < 8; ++j) {
    const int k = kk + 8 * j;
    float v = 0.f;
    if (n_src0 >= 0 && (n_src0 + n) < nsrc_valid) { v = src[(size_t)(k0 + k) * ldsrc + n_src0 + n]; if (gain) v *= gain[k0 + k]; }
    tl[n * LDT + k] = f2bf(v);
  }
  __syncthreads();
  { const int nn = tid >> 3, kc = tid & 7;
    *(uint4*)(dst + (size_t)(n_dst0 + nn) * K + k0 + kc * 8) = *(const uint4*)(tl + nn * LDT + kc * 8); }
  __syncthreads();
}

DEVI void transpose_weight(const float* __restrict__ src, int Ksz, int Nsrc, int Ndst, const float* __restrict__ gain, bf16_t* __restrict__ dst, int remap_ab, unsigned char* smem) {
  const int nkt = Ksz / 64, nnt = Ndst / 32, total = nkt * nnt;
  bf16_t* tl = (bf16_t*)smem;
  const int tid = tid_();
  const int n = tid & 31, kk = tid >> 5;
  float v[8], vn[8];
  auto src_col = [&](int d0) { int s0 = d0; if (remap_ab) { if (d0 < 640) s0 = d0; else if (d0 < 3200) s0 = d0 + 32; else if (d0 < 3232) s0 = 640; else s0 = -1; } else if (d0 >= Nsrc) s0 = -1; return s0; };
#define TLOAD_(dstv, it_) do { const int nt_ = (it_) / nkt, kt_ = (it_) - nt_ * nkt; const int s0_ = src_col(nt_ * 32); const bool ok_ = (s0_ >= 0) && ((s0_ + n) < Nsrc); \
    _Pragma("unroll") for (int j = 0; j < 8; ++j) { const int k_ = kt_ * 64 + kk + 8 * j; float x_ = 0.f; if (ok_) { x_ = src[(size_t)k_ * Nsrc + s0_ + n]; if (gain) x_ *= gain[k_]; } dstv[j] = x_; } } while (0)
  int it = blockIdx.x;
  if (it < total) TLOAD_(v, it);
  for (; it < total; it += gridDim.x) {
    const int nt = it / nkt, kt = it - nt * nkt, d0 = nt * 32, k0 = kt * 64;
    const int itn = it + gridDim.x;
    if (itn < total) TLOAD_(vn, itn);
#pragma unroll
    for (int j = 0; j < 8; ++j) tl[n * LDT + kk + 8 * j] = f2bf(v[j]);
    __syncthreads();
    { const int nn = tid >> 3, kc = tid & 7;
      *(uint4*)(dst + (size_t)(d0 + nn) * Ksz + k0 + kc * 8) = *(const uint4*)(tl + nn * LDT + kc * 8); }
    __syncthreads();
#pragma unroll
    for (int j = 0; j < 8; ++j) v[j] = vn[j];
  }
#undef TLOAD_
}

DEVI void norm_rows(const float* __restrict__ src, const float* __restrict__ gain, bf16_t* __restrict__ dst) {
  const int lane = tid_() & 63, w = tid_() >> 6;
  f32x4 g[4];
#pragma unroll
  for (int j = 0; j < 4; ++j) g[j] = *(const f32x4*)(gain + (j * 64 + lane) * 4);
  for (int it = blockIdx.x; it < T_ / 16; it += gridDim.x) {
    const int row0 = it * 16 + w * 4;
    f32x4 v[4][4]; float sq[4];
#pragma unroll
    for (int rr = 0; rr < 4; ++rr)
#pragma unroll
      for (int j = 0; j < 4; ++j) v[rr][j] = *(const f32x4*)(src + (size_t)(row0 + rr) * 1024 + (j * 64 + lane) * 4);
#pragma unroll
    for (int rr = 0; rr < 4; ++rr) {
      float a = 0.f;
#pragma unroll
      for (int j = 0; j < 4; ++j) a += v[rr][j][0] * v[rr][j][0] + v[rr][j][1] * v[rr][j][1] + v[rr][j][2] * v[rr][j][2] + v[rr][j][3] * v[rr][j][3];
      sq[rr] = a;
    }
#pragma unroll
    for (int rr = 0; rr < 4; ++rr) sq[rr] += shx<1>(sq[rr]);
#pragma unroll
    for (int rr = 0; rr < 4; ++rr) sq[rr] += shx<2>(sq[rr]);
#pragma unroll
    for (int rr = 0; rr < 4; ++rr) sq[rr] += shx<4>(sq[rr]);
#pragma unroll
    for (int rr = 0; rr < 4; ++rr) sq[rr] += shx<8>(sq[rr]);
#pragma unroll
    for (int rr = 0; rr < 4; ++rr) sq[rr] += shx<16>(sq[rr]);
#pragma unroll
    for (int rr = 0; rr < 4; ++rr) sq[rr] += shx<32>(sq[rr]);
#pragma unroll
    for (int rr = 0; rr < 4; ++rr) {
      const float rs = rsqrtf(sq[rr] * (1.f / 1024.f) + EPS_);
#pragma unroll
      for (int j = 0; j < 4; ++j) {
        uint2 o; o.x = cvt_pk_bf16(v[rr][j][0] * rs * g[j][0], v[rr][j][1] * rs * g[j][1]); o.y = cvt_pk_bf16(v[rr][j][2] * rs * g[j][2], v[rr][j][3] * rs * g[j][3]);
        *(uint2*)(dst + (size_t)(row0 + rr) * 1024 + (j * 64 + lane) * 4) = o;
      }
    }
  }
}

DEVI void phase_prep(const Params& P, int layer, unsigned char* smem) {
  const int l = layer >> 1;
  const float* hin = layer == 0 ? P.x : P.out;
  norm_rows(hin, P.norm_g + layer * 1024, P.uy);
  if ((layer & 1) == 0) {
    transpose_weight(P.ab_w_in + (size_t)l * 1024 * 3232, 1024, 3232, 3328, nullptr, P.wt_in, 1, smem);
    transpose_weight(P.mla_w_uq + (size_t)l * 384 * 768, 384, 768, 768, P.mla_q_norm + l * 384, P.wt_uq, 0, smem);
    transpose_weight(P.mla_w_ukv + (size_t)l * 256 * 1024, 256, 1024, 1024, P.mla_kv_norm + l * 256, P.wt_ukv, 0, smem);
    transpose_weight(P.ab_w_out + (size_t)l * 1024 * 1024, 1024, 1024, 1024, nullptr, P.wt_out, 0, smem);
  } else {
    transpose_weight(P.fox_w_in + (size_t)l * 1024 * 4112, 1024, 4112, 4224, nullptr, P.wt_in, 0, smem);
    transpose_weight(P.fox_w_out + (size_t)l * 1024 * 1024, 1024, 1024, 1024, nullptr, P.wt_out, 0, smem);
  }
  transpose_weight(P.pe_w + (size_t)layer * 256 * 1024, 256, 1024, 1024, nullptr, P.wt_pe, 0, smem);
  transpose_weight(P.pe_gate_w + (size_t)layer * 1024 * 1024, 1024, 1024, 1024, P.pe_gate_norm + layer * 1024, P.wt_gate, 0, smem);
  if (layer == 0) {
    for (int it = blockIdx.x; it < T_ * 16 / 256; it += gridDim.x) {
      const int e = it * 256 + tid_(), tok = e >> 4, i = e & 15;
      double invf = 1.0;
      for (int q = 0; q < i; ++q) invf *= 0.5623413251903491;
      const double rev = (double)P.pos[tok] * invf * 0.15915494309189535;
      const float fr = (float)(rev - floor(rev));
      P.cosT[e] = __builtin_amdgcn_cosf(fr); P.sinT[e] = __builtin_amdgcn_sinf(fr);
    }
  }
}

DEVI void epi_in_even(const Params& P, int l, const f32x16 (&acc)[4], int rt, int ct, unsigned char* smem) {
  const int row0 = rt * 128;
  bf16_t* zr = P.z + (size_t)row0 * ZE;
  bf16_t* ot = (bf16_t*)smem;
  if (ct < 5) { epi_store(acc, ot, false, 4); copy_out<16>(ot, zr + ct * 128, ZE, 128); }
  else if (ct < 9) { epi_store(acc, ot, true, 4); copy_out<16>(ot, zr + ct * 128, ZE, 128); }
  else if (ct < 13) { epi_qknorm(acc, P.chk_q_gain + l * 64, 0.125f * LOG2E_, ot); copy_out<16>(ot, zr + ct * 128, ZE, 128); }
  else if (ct < 17) { epi_qknorm(acc, P.chk_k_gain + l * 64, 1.f, ot); copy_out<16>(ot, zr + ct * 128, ZE, 128); }
  else if (ct < 21) {
    const int b = row0 / S_, s0 = row0 % S_, hd = (ct - 17) * 2;
    epi_vt(acc[0], acc[1], ot, 0); epi_vt(acc[2], acc[3], ot, 64);
    copy_out<16>(ot, P.vt + ((size_t)(b * 8 + hd) * 64) * S_ + s0, S_, 128);
  }
  else if (ct < 25) { epi_store(acc, ot, true, 4); copy_out<16>(ot, zr + ct * 128 - 512, ZE, 128); }
  else { epi_store(acc, ot, false, 1); copy_out<4>(ot, zr + 2688, ZE, 128); }
}
DEVI void phase_in_even(const Params& P, int l, unsigned char* smem) {
  constexpr int NCT = 26, NPAIR = 1536;
  const int G = gridDim.x;
  TileIter ti; tile_begin(ti, NCT, 64, NPAIR);
  for (int rp, ct; tile_next(ti, rp, ct);) {
    f32x16 acc0[4], acc1[4]; zero_acc<4>(acc0); zero_acc<4>(acc1);
    gemm_mainloop2(P.uy + (size_t)(2 * rp) * 128 * 1024, P.uy + (size_t)(2 * rp + 1) * 128 * 1024, 1024, P.wt_in + (size_t)ct * 128 * 1024, 1024, 1024, acc0, acc1, smem);
    epi_in_even(P, l, acc0, 2 * rp, ct, smem);
    epi_in_even(P, l, acc1, 2 * rp + 1, ct, smem);
  }
  for (int s = blockIdx.x; s < 2 * (64 * NCT - NPAIR); s += G) {
    int rp, ct; decode_item(NPAIR + (s >> 1), NCT, 64, rp, ct);
    const int rt = 2 * rp + (s & 1);
    f32x16 acc[4]; zero_acc<4>(acc); f32x4 ss;
    gemm_mainloop<128, false>(P.uy + (size_t)rt * 128 * 1024, 1024, P.wt_in + (size_t)ct * 128 * 1024, 1024, 1024, acc, smem, ss);
    epi_in_even(P, l, acc, rt, ct, smem);
  }
}

DEVI void epi_in_odd(const Params& P, int l, const f32x16 (&acc)[4], int rt, int ct, unsigned char* smem) {
  const int row0 = rt * 128;
  bf16_t* zr = P.z + (size_t)row0 * ZO;
  bf16_t* ot = (bf16_t*)smem;
  if (ct < 8) { epi_qknorm(acc, P.fox_q_gain + l * 64, 0.125f * LOG2E_, ot); copy_out<16>(ot, zr + ct * 128, ZO, 128); }
  else if (ct < 16) { epi_qknorm(acc, P.fox_k_gain + l * 64, 1.f, ot); copy_out<16>(ot, zr + ct * 128, ZO, 128); }
  else if (ct < 24) {
    const int b = row0 / S_, s0 = row0 % S_, hd = (ct - 16) * 2;
    epi_vt(acc[0], acc[1], ot, 0); epi_vt(acc[2], acc[3], ot, 64);
    copy_out<16>(ot, P.vt + ((size_t)(b * 16 + hd) * 64) * S_ + s0, S_, 128);
  }
  else if (ct < 32) { epi_store(acc, ot, true, 4); copy_out<16>(ot, zr + (ct - 24) * 128 + 2048, ZO, 128); }
  else {
    const int lane = tid_() & 63, w = tid_() >> 6, fr = lane & 31, fh = lane >> 5;
    if (fr < 16) {
      const float bf = P.fox_b_f[l * 16 + fr];
#pragma unroll
      for (int r = 0; r < 16; ++r) {
        const float xv = acc[0][r] + bf;
        const float ls = fminf(xv, 0.f) - log1pf(expf(-fabsf(xv)));
        int orow = ROW_OF(r); asm volatile("" : "+v"(orow));
        P.logf[(size_t)(row0 + orow) * 16 + fr] = ls * LOG2E_;
        FENCE();
      }
    }
  }
}
DEVI void phase_in_odd(const Params& P, int l, unsigned char* smem) {
  const int G = gridDim.x;
  TileIter ti; tile_begin(ti, 32, 64);
  for (int rp, ct; tile_next(ti, rp, ct);) {
    f32x16 acc0[4], acc1[4]; zero_acc<4>(acc0); zero_acc<4>(acc1);
    gemm_mainloop2(P.uy + (size_t)(2 * rp) * 128 * 1024, P.uy + (size_t)(2 * rp + 1) * 128 * 1024, 1024, P.wt_in + (size_t)ct * 128 * 1024, 1024, 1024, acc0, acc1, smem);
    epi_in_odd(P, l, acc0, 2 * rp, ct, smem);
    epi_in_odd(P, l, acc1, 2 * rp + 1, ct, smem);
  }
  for (int rt = blockIdx.x; rt < 128; rt += G) {
    f32x16 acc[4]; zero_acc<4>(acc); f32x4 ss;
    f32x16 (&acc1)[1] = *(f32x16 (*)[1])&acc[0];
    gemm_mainloop<32, false>(P.uy + (size_t)rt * 128 * 1024, 1024, P.wt_in + (size_t)32 * 128 * 1024, 1024, 1024, acc1, smem, ss);
    epi_in_odd(P, l, acc, rt, 32, smem);
  }
}

DEVI void phase_mla_up(const Params& P, int l, unsigned char* smem) {
  const int G = gridDim.x;
  float* rowstat = (float*)(smem + 73728);
  bf16_t* ot = (bf16_t*)smem;
  const int tid = tid_(), lane = tid & 63, w = tid >> 6, fr = lane & 31, fh = lane >> 5;
  for (int tile = vbid(); tile < 2048; tile += G) {
    const bool isq = tile < 1024;
    const int tt = isq ? tile : tile - 1024;
    const int rt = tt >> 3, hd = tt & 7;
    const int row0 = rt * 128, b = row0 / S_, s0 = row0 % S_;
    f32x4 ss;
    if (isq) {
      f32x16 acc[3]; zero_acc<3>(acc);
      gemm_mainloop<96, true, true>(P.z + (size_t)row0 * ZE, ZE, P.wt_uq + (size_t)hd * 96 * 384, 384, 384, acc, smem, ss);
#pragma unroll
      for (int i = 0; i < 4; ++i) { float v = ss[i]; v += shx<1>(v); v += shx<2>(v); v += shx<4>(v); if ((tid & 7) == 0) rowstat[(tid >> 3) + 32 * i] = rsqrtf(v * (1.f / 384.f) + EPS_); }
      __syncthreads();
      const float g0 = P.mla_q_gain[l * 96 + fr], g1 = P.mla_q_gain[l * 96 + 32 + fr], g2 = P.mla_q_gain[l * 96 + 64 + fr];
      const float qs = 0.10206207261596577f * LOG2E_;
      bf16_t* qd = P.qm + ((size_t)(b * 8 + hd) * S_ + s0) * 96;
      float cs[16], sn_[16];
#pragma unroll
      for (int r = 0; r < 16; ++r) { const size_t ti = (size_t)(row0 + ROW_OF(r)) * 16 + (fr & 15); cs[r] = P.cosT[ti]; sn_[r] = P.sinT[ti]; }
#pragma unroll
      for (int r = 0; r < 16; ++r) {
        const int row = ROW_OF(r);
        const float rs = rowstat[row];
        const float v0 = acc[0][r] * rs, v1 = acc[1][r] * rs, v2 = acc[2][r] * rs;
        const float sq = hsum32(v0 * v0 + v1 * v1 + v2 * v2);
        const float r2 = rsqrtf(sq * (1.f / 96.f) + EPS_) * qs;
        const float q0 = v0 * r2 * g0, q1 = v1 * r2 * g1, q2 = v2 * r2 * g2;
        const float pr = shx<16>(q2);
        const float c = cs[r], sn = sn_[r];
        const float q2r = (fr < 16) ? q2 * c - pr * sn : q2 * c + pr * sn;
        bf16_t* d = ot + row * OLD + fr;
        d[0] = f2bf(q0); d[32] = f2bf(q1); d[64] = f2bf(q2r);
      }
      copy_out<12>(ot, qd, 96, 128);
    } else {
      f32x16 acc[4]; zero_acc<4>(acc);
      gemm_mainloop<128, true, false>(P.z + (size_t)row0 * ZE + 384, ZE, P.wt_ukv + (size_t)hd * 128 * 256, 256, 256, acc, smem, ss);
#pragma unroll
      for (int i = 0; i < 4; ++i) { float v = ss[i]; v += shx<1>(v); v += shx<2>(v); v += shx<4>(v); if ((tid & 7) == 0) rowstat[(tid >> 3) + 32 * i] = rsqrtf(v * (1.f / 256.f) + EPS_); }
      __syncthreads();
      const float g0 = P.mla_k_gain[l * 96 + fr], g1 = P.mla_k_gain[l * 96 + 32 + fr], g2 = P.mla_k_gain[l * 96 + 64 + fr];
      bf16_t* kd = P.km + ((size_t)(b * 8 + hd) * S_ + s0) * 96;
      float cs[16], sn_[16], krv[16];
#pragma unroll
      for (int r = 0; r < 16; ++r) { const size_t ti = (size_t)(row0 + ROW_OF(r)) * 16 + (fr & 15); cs[r] = P.cosT[ti]; sn_[r] = P.sinT[ti];
        krv[r] = bf2f(P.z[(size_t)(row0 + ROW_OF(r)) * ZE + 2688 + fr]); }
#pragma unroll
      for (int r = 0; r < 16; ++r) {
        const int row = ROW_OF(r);
        const float rs = rowstat[row];
        const float v0 = acc[0][r] * rs, v1 = acc[1][r] * rs;
        acc[2][r] *= rs; acc[3][r] *= rs;
        const float kr = krv[r];
        const float sq = hsum32(v0 * v0 + v1 * v1 + kr * kr);
        const float r2 = rsqrtf(sq * (1.f / 96.f) + EPS_);
        const float k0 = v0 * r2 * g0, k1 = v1 * r2 * g1, k2 = kr * r2 * g2;
        const float pr = shx<16>(k2);
        const float c = cs[r], sn = sn_[r];
        const float k2r = (fr < 16) ? k2 * c - pr * sn : k2 * c + pr * sn;
        bf16_t* d = ot + row * OLD + fr;
        d[0] = f2bf(k0); d[32] = f2bf(k1); d[64] = f2bf(k2r);
      }
      epi_vt(acc[2], acc[3], ot + 128 * OLD, 0);
      copy_out<12>(ot, kd, 96, 128);
      copy_out<16>(ot + 128 * OLD, P.vtm + ((size_t)(b * 8 + hd) * 64) * S_ + s0, S_, 64);
    }
  }
}

DEVI void phase_scan(const Params& P, unsigned char* smem) {
  double* tot = (double*)smem;
  const int tid = tid_();
  for (int seq = blockIdx.x; seq < 32; seq += gridDim.x) {
    const int b = seq >> 4, h = seq & 15;
    const float* lp = P.logf + ((size_t)b * S_ + tid * 32) * 16 + h;
    float lv[32];
#pragma unroll
    for (int j = 0; j < 32; ++j) lv[j] = lp[(size_t)j * 16];
    double a = 0.0;
#pragma unroll
    for (int j = 0; j < 32; ++j) a += (double)lv[j];
    tot[tid] = a;
    __syncthreads();
    double off = 0.0;
    for (int j = 0; j < tid; ++j) off += tot[j];
    float* cp = P.cum + (size_t)seq * S_ + tid * 32;
#pragma unroll
    for (int j = 0; j < 32; j += 4) {
      f32x4 o4;
#pragma unroll
      for (int q = 0; q < 4; ++q) { off += (double)lv[j + q]; o4[q] = (float)off; }
      *(f32x4*)(cp + j) = o4;
    }
    __syncthreads();
  }
}

template <int DK, int MODE>
DEVI void attn_unit(const Params& P, int l, int b, int hd, int qb, unsigned char* smem) {
  constexpr int LDK = DK + 8, NKS = DK / 16, KCH = DK / 8, NKL = (64 * KCH) / 256;
  bf16_t* Ks = (bf16_t*)smem;
  bf16_t* Vs = Ks + 2 * 64 * LDK;
  float* ckS = (float*)(Vs + 2 * 64 * LDT);
  float* tbl = ckS + 128;
  const int tid = tid_(), lane = tid & 63, w = tid >> 6, fr = lane & 31, fh = lane >> 5;
  const int q0 = qb * 128;
  const size_t tok0 = (size_t)b * S_;
  const bf16_t *Qp, *Kp, *Vp, *Gp; int ldq, ldk, ldg; bf16_t* Yp; const float* cump = nullptr;
  if (MODE == 0) {
    Qp = P.qm + ((size_t)(b * 8 + hd) * S_) * 96; ldq = 96; Kp = P.km + ((size_t)(b * 8 + hd) * S_) * 96; ldk = 96;
    Vp = P.vtm + ((size_t)(b * 8 + hd) * 64) * S_; Gp = P.z + tok0 * ZE + 640 + hd * 64; ldg = ZE; Yp = P.uy + tok0 * 1024 + hd * 64;
  } else if (MODE == 1) {
    Qp = P.z + tok0 * ZE + 1152 + hd * 64; ldq = ZE; Kp = P.z + tok0 * ZE + 1664 + hd * 64; ldk = ZE;
    Vp = P.vt + ((size_t)(b * 8 + hd) * 64) * S_; Gp = P.z + tok0 * ZE + 2176 + hd * 64; ldg = ZE; Yp = P.uy + tok0 * 1024 + 512 + hd * 64;
  } else {
    Qp = P.z + tok0 * ZO + hd * 64; ldq = ZO; Kp = P.z + tok0 * ZO + 1024 + hd * 64; ldk = ZO;
    Vp = P.vt + ((size_t)(b * 16 + hd) * 64) * S_; Gp = P.z + tok0 * ZO + 2048 + hd * 64; ldg = ZO; Yp = P.uy + tok0 * 1024 + hd * 64;
    cump = P.cum + (size_t)(b * 16 + hd) * S_;
  }
  int kt_begin = (MODE == 1) ? max(0, 2 * qb - 8) : 0;
  float qkb2 = 0.f;
  const int kt_end = 2 * qb + 2;
  if (MODE == 2) {
    float gq = fabsf(P.fox_q_gain[l * 64 + lane]), gk = fabsf(P.fox_k_gain[l * 64 + lane]);
    gq = fmaxf(gq, shx<1>(gq)); gq = fmaxf(gq, shx<2>(gq)); gq = fmaxf(gq, shx<4>(gq)); gq = fmaxf(gq, shx<8>(gq)); gq = fmaxf(gq, shx<16>(gq)); gq = fmaxf(gq, shx<32>(gq));
    gk = fmaxf(gk, shx<1>(gk)); gk = fmaxf(gk, shx<2>(gk)); gk = fmaxf(gk, shx<4>(gk)); gk = fmaxf(gk, shx<8>(gk)); gk = fmaxf(gk, shx<16>(gk)); gk = fmaxf(gk, shx<32>(gk));
    qkb2 = 8.f * gq * gk * LOG2E_ * 1.05f;
    const float thr = 2.f * qkb2 + 40.f;
    int* skb = (int*)(tbl + 520);
    if (tid == 0) *skb = 2 * qb;
    __syncthreads();
    if (tid < 2 * qb) { if (!((cump[64 * tid + 63] - cump[q0]) > thr)) atomicMin(skb, tid); }
    __syncthreads();
    kt_begin = *skb;
  }
  const int qc = 2 * qb + (w >> 1);
  bf16x8 qf[NKS];
  { const bf16_t* qp = Qp + (size_t)(q0 + 32 * w + fr) * ldq + 8 * fh;
#pragma unroll
    for (int ks = 0; ks < NKS; ++ks) qf[ks] = *(const bf16x8*)(qp + 16 * ks); }
  float cq2 = 0.f;
  if (MODE == 2) cq2 = cump[q0 + 32 * w + fr];
  if (MODE == 1) {
    for (int i = tid; i < 513; i += 256) tbl[i] = P.chk_rel_bias[((size_t)l * 8 + hd) * 513 + i] * LOG2E_;
    float gq = fabsf(P.chk_q_gain[l * 64 + lane]), gk = fabsf(P.chk_k_gain[l * 64 + lane]), bm = 0.f;
    for (int i = lane; i < 513; i += 64) bm = fmaxf(bm, fabsf(P.chk_rel_bias[((size_t)l * 8 + hd) * 513 + i]));
    gq = fmaxf(gq, shx<1>(gq)); gq = fmaxf(gq, shx<2>(gq)); gq = fmaxf(gq, shx<4>(gq)); gq = fmaxf(gq, shx<8>(gq)); gq = fmaxf(gq, shx<16>(gq)); gq = fmaxf(gq, shx<32>(gq));
    gk = fmaxf(gk, shx<1>(gk)); gk = fmaxf(gk, shx<2>(gk)); gk = fmaxf(gk, shx<4>(gk)); gk = fmaxf(gk, shx<8>(gk)); gk = fmaxf(gk, shx<16>(gk)); gk = fmaxf(gk, shx<32>(gk));
    bm = fmaxf(bm, shx<1>(bm)); bm = fmaxf(bm, shx<2>(bm)); bm = fmaxf(bm, shx<4>(bm)); bm = fmaxf(bm, shx<8>(bm)); bm = fmaxf(bm, shx<16>(bm)); bm = fmaxf(bm, shx<32>(bm));
    qkb2 = (8.f * gq * gk * 1.05f + bm) * LOG2E_;
  }
  if (MODE == 0) {
    float gq = fmaxf(fabsf(P.mla_q_gain[l * 96 + lane]), fabsf(P.mla_q_gain[l * 96 + 32 + lane])), gk = fmaxf(fabsf(P.mla_k_gain[l * 96 + lane]), fabsf(P.mla_k_gain[l * 96 + 32 + lane]));
    gq = fmaxf(gq, shx<1>(gq)); gq = fmaxf(gq, shx<2>(gq)); gq = fmaxf(gq, shx<4>(gq)); gq = fmaxf(gq, shx<8>(gq)); gq = fmaxf(gq, shx<16>(gq)); gq = fmaxf(gq, shx<32>(gq));
    gk = fmaxf(gk, shx<1>(gk)); gk = fmaxf(gk, shx<2>(gk)); gk = fmaxf(gk, shx<4>(gk)); gk = fmaxf(gk, shx<8>(gk)); gk = fmaxf(gk, shx<16>(gk)); gk = fmaxf(gk, shx<32>(gk));
    qkb2 = 9.797958971f * gq * gk * LOG2E_ * 1.05f;
  }
  const bool fixedm = qkb2 <= 40.f;
  uint4 rk0, rk1, rk2, rv0, rv1; float rc = 0.f;
  rk2 = make_uint4(0, 0, 0, 0);
  const int kr0 = tid / KCH, kc0 = tid % KCH, kr1 = (tid + 256) / KCH, kc1 = (tid + 256) % KCH, kr2 = (tid + 512) / KCH, kc2 = (tid + 512) % KCH;
  const int vr0 = tid >> 3, vc0 = tid & 7;
#define AGL_(kt_) do { const int k0_ = (kt_) * 64; \
    rk0 = *(const uint4*)(Kp + (size_t)(k0_ + kr0) * ldk + kc0 * 8); rk1 = *(const uint4*)(Kp + (size_t)(k0_ + kr1) * ldk + kc1 * 8); \
    if (NKL > 2) rk2 = *(const uint4*)(Kp + (size_t)(k0_ + kr2) * ldk + kc2 * 8); \
    rv0 = *(const uint4*)(Vp + (size_t)vr0 * S_ + k0_ + vc0 * 8); rv1 = *(const uint4*)(Vp + (size_t)(vr0 + 32) * S_ + k0_ + vc0 * 8); \
    if (MODE == 2) { if (tid < 64) rc = cump[k0_ + tid]; } } while (0)
#define AST_(buf) do { bf16_t* k_ = Ks + (buf) * 64 * LDK; bf16_t* v_ = Vs + (buf) * 64 * LDT; \
    *(uint4*)(k_ + kr0 * LDK + kc0 * 8) = rk0; *(uint4*)(k_ + kr1 * LDK + kc1 * 8) = rk1; if (NKL > 2) *(uint4*)(k_ + kr2 * LDK + kc2 * 8) = rk2; \
    *(uint4*)(v_ + vr0 * LDT + vc0 * 8) = rv0; *(uint4*)(v_ + (vr0 + 32) * LDT + vc0 * 8) = rv1; \
    if (MODE == 2) { if (tid < 64) ckS[(buf) * 64 + tid] = rc; } } while (0)
  f32x16 o[2];
#pragma unroll
  for (int r = 0; r < 16; ++r) { o[0][r] = 0.f; o[1][r] = 0.f; }
  float m = fixedm ? qkb2 : -1e30f, lsum = 0.f;
  const float sbase = ((MODE == 2) ? cq2 : 0.f) - (fixedm ? qkb2 : 0.f);
  const int pfr = (fr & 0x13) | ((fr & 4) << 1) | ((fr & 8) >> 1);
  AGL_(kt_begin); AST_(0);
  __syncthreads();
#pragma unroll 1
  for (int kt = kt_begin; kt < kt_end; ++kt) {
    const int cur = (kt - kt_begin) & 1;
    if (kt + 1 < kt_end) AGL_(kt + 1);
    bool active;
    if (MODE == 0) active = kt <= qc;
    else if (MODE == 1) active = (kt <= qc) && (kt >= qc - 8);
    else active = (64 * kt) <= (q0 + 32 * w + 31);
    if (active) {
      f32x16 s[2];
      float sinit = sbase;
      bool farb = false;
      if (MODE == 1) { farb = (64 * (qc - kt) + 32 * (w & 1) - 63) >= 256; if (farb) sinit += tbl[512]; }
#pragma unroll
      for (int r = 0; r < 16; ++r) { s[0][r] = sinit; s[1][r] = sinit; }
      const bf16_t* Kc = Ks + cur * 64 * LDK + pfr * LDK + 8 * fh;
      {
        bf16x8 xa = *(const bf16x8*)(Kc), xb = *(const bf16x8*)(Kc + 32 * LDK);
#pragma unroll
        for (int ks = 0; ks < NKS; ++ks) {
          bf16x8 ya = xa, yb = xb;
          if (ks + 1 < NKS) { ya = *(const bf16x8*)(Kc + 16 * (ks + 1)); yb = *(const bf16x8*)(Kc + 32 * LDK + 16 * (ks + 1)); }
          __builtin_amdgcn_sched_barrier(0);
          s[0] = __builtin_amdgcn_mfma_f32_32x32x16_bf16(xa, qf[ks], s[0], 0, 0, 0);
          s[1] = __builtin_amdgcn_mfma_f32_32x32x16_bf16(xb, qf[ks], s[1], 0, 0, 0);
          __builtin_amdgcn_sched_barrier(0);
          xa = ya; xb = yb;
        }
      }
      if (MODE == 2) {
        const bool diag = (64 * kt + 63) > (q0 + 32 * w);
        const int qrel = q0 + 32 * w + fr - 64 * kt;
#pragma unroll
        for (int t = 0; t < 2; ++t)
#pragma unroll
          for (int g = 0; g < 4; ++g) {
            const int sb = 32 * t + 16 * (g >> 1) + 8 * fh + 4 * (g & 1);
            const f32x4 ck = *(const f32x4*)(ckS + cur * 64 + sb);
#pragma unroll
            for (int bb = 0; bb < 4; ++bb) {
              float v = s[t][4 * g + bb] - ck[bb];
              if (diag && (sb + bb) > qrel) v = -1e30f;
              s[t][4 * g + bb] = v;
            }
          }
      } else if (MODE == 1) {
        const int Dd = 64 * (qc - kt) + 32 * (w & 1) + fr;
        if (!farb) {
#pragma unroll
          for (int t = 0; t < 2; ++t)
#pragma unroll
            for (int r = 0; r < 16; ++r) {
              const int slot = 32 * t + 16 * (r >> 3) + 8 * fh + 4 * ((r >> 2) & 1) + (r & 3);
              const int idx = min(Dd - slot, 256) + 256;
              s[t][r] += tbl[idx];
            }
        }
      }
      float mx = m;
      if (!fixedm) {
        mx = fmaxf(s[0][0], s[1][0]);
#pragma unroll
        for (int r = 1; r < 16; ++r) mx = fmaxf(mx, fmaxf(s[0][r], s[1][r]));
        mx = fmaxf(mx, shx<32>(mx));
      }
      if (!fixedm && __builtin_amdgcn_ballot_w64(mx > m) != 0ull) {
        const float mn = fmaxf(m, mx);
        const float alpha = __builtin_amdgcn_exp2f(m - mn);
        m = mn; lsum *= alpha;
#pragma unroll
        for (int r = 0; r < 16; ++r) { o[0][r] *= alpha; o[1][r] *= alpha; }
      }
      float ps = 0.f;
      if (fixedm) {
#pragma unroll
        for (int t = 0; t < 2; ++t)
#pragma unroll
          for (int r = 0; r < 16; ++r) { const float pv = __builtin_amdgcn_exp2f(s[t][r]); s[t][r] = pv; ps += pv; }
      } else {
#pragma unroll
        for (int t = 0; t < 2; ++t)
#pragma unroll
          for (int r = 0; r < 16; ++r) { const float pv = __builtin_amdgcn_exp2f(s[t][r] - m); s[t][r] = pv; ps += pv; }
      }
      lsum += ps;
      const bf16_t* Vc = Vs + cur * 64 * LDT + fr * LDT + 8 * fh;
      {
        bf16x8 v0 = *(const bf16x8*)(Vc), v1 = *(const bf16x8*)(Vc + 32 * LDT);
#pragma unroll
        for (int i = 0; i < 4; ++i) {
          const int t = i >> 1, si = i & 1;
          bf16x8 n0 = v0, n1 = v1;
          if (i < 3) { const int t2 = (i + 1) >> 1, s2 = (i + 1) & 1; n0 = *(const bf16x8*)(Vc + 32 * t2 + 16 * s2); n1 = *(const bf16x8*)(Vc + 32 * LDT + 32 * t2 + 16 * s2); }
          u32x4 pku;
          pku[0] = cvt_pk_bf16(s[t][8 * si + 0], s[t][8 * si + 1]); pku[1] = cvt_pk_bf16(s[t][8 * si + 2], s[t][8 * si + 3]);
          pku[2] = cvt_pk_bf16(s[t][8 * si + 4], s[t][8 * si + 5]); pku[3] = cvt_pk_bf16(s[t][8 * si + 6], s[t][8 * si + 7]);
          const bf16x8 pkv = __builtin_bit_cast(bf16x8, pku);
          __builtin_amdgcn_sched_barrier(0);
          o[0] = __builtin_amdgcn_mfma_f32_32x32x16_bf16(v0, pkv, o[0], 0, 0, 0);
          o[1] = __builtin_amdgcn_mfma_f32_32x32x16_bf16(v1, pkv, o[1], 0, 0, 0);
          __builtin_amdgcn_sched_barrier(0);
          v0 = n0; v1 = n1;
        }
      }
    }
    if (kt + 1 < kt_end) AST_(cur ^ 1);
    __syncthreads();
  }
  lsum += shx<32>(lsum);
  const float inv = 1.f / lsum;
  const size_t trow = (size_t)(q0 + 32 * w + fr);
  uint2 ggv[2][4];
#pragma unroll
  for (int u = 0; u < 2; ++u)
#pragma unroll
    for (int g = 0; g < 4; ++g) ggv[u][g] = *(const uint2*)(Gp + trow * ldg + 32 * u + 8 * g + 4 * fh);
#pragma unroll
  for (int u = 0; u < 2; ++u)
#pragma unroll
    for (int g = 0; g < 4; ++g) {
      const int dv = 32 * u + 8 * g + 4 * fh;
      const uint2 gg = ggv[u][g];
      const float g0 = __uint_as_float(gg.x << 16), g1 = __uint_as_float(gg.x & 0xffff0000u), g2 = __uint_as_float(gg.y << 16), g3 = __uint_as_float(gg.y & 0xffff0000u);
      uint2 ov; ov.x = cvt_pk_bf16(o[u][4 * g] * inv * g0, o[u][4 * g + 1] * inv * g1); ov.y = cvt_pk_bf16(o[u][4 * g + 2] * inv * g2, o[u][4 * g + 3] * inv * g3);
      *(uint2*)(Yp + trow * 1024 + dv) = ov;
    }
}

DEVI int zigzag(int r, int G, int bid) { return r * G + ((r & 1) ? (G - 1 - bid) : bid); }

DEVI void phase_attn_even(const Params& P, int l, unsigned char* smem) {
  const int G = gridDim.x;
  for (int r = 0;; ++r) {
    const int j = zigzag(r, G, blockIdx.x);
    if (r * G >= 2048) break;
    if (j >= 2048) continue;
    if (j < 1024) { const int qb = 63 - (j >> 4), bh = j & 15; attn_unit<96, 0>(P, l, bh >> 3, bh & 7, qb, smem); }
    else { const int jj = j - 1024; const int qb = 63 - (jj >> 4), bh = jj & 15; attn_unit<64, 1>(P, l, bh >> 3, bh & 7, qb, smem); }
  }
}
DEVI void phase_attn_odd(const Params& P, int l, unsigned char* smem) {
  const int G = gridDim.x;
  for (int r = 0;; ++r) {
    const int j = zigzag(r, G, blockIdx.x);
    if (r * G >= 2048) break;
    if (j >= 2048) continue;
    const int qb = 63 - (j >> 5), bh = j & 31;
    attn_unit<64, 2>(P, l, bh >> 4, bh & 15, qb, smem);
  }
}

DEVI void phase_outproj(const Params& P, int layer, unsigned char* smem) {
  const float* hin = layer == 0 ? P.x : P.out;
  TileIter ti; tile_begin(ti, 8, 64);
  for (int rp, ct; tile_next(ti, rp, ct);) {
    f32x16 acc0[4], acc1[4]; zero_acc<4>(acc0); zero_acc<4>(acc1);
    gemm_mainloop2(P.uy + (size_t)(2 * rp) * 128 * 1024, P.uy + (size_t)(2 * rp + 1) * 128 * 1024, 1024, P.wt_out + (size_t)ct * 128 * 1024, 1024, 1024, acc0, acc1, smem);
    { stage_f32(acc0, (float*)smem); const size_t org = (size_t)(2 * rp * 128) * 1024 + ct * 128; residual_out((const float*)smem, hin + org, (float*)P.z + org); }
    { stage_f32(acc1, (float*)smem); const size_t org = (size_t)((2 * rp + 1) * 128) * 1024 + ct * 128; residual_out((const float*)smem, hin + org, (float*)P.z + org); }
  }
}

DEVI void phase_norm2(const Params& P, int layer) {
  norm_rows(P.out, P.pe_gate_norm + layer * 1024, P.uy);
  const float* pp = P.p + (size_t)layer * T_ * 256;
  for (int it = blockIdx.x; it < T_ * 256 / 2048; it += gridDim.x) {
    const size_t e = (size_t)it * 2048 + tid_() * 8;
    const f32x4 a = *(const f32x4*)(pp + e), c = *(const f32x4*)(pp + e + 4);
    uint4 o; o.x = cvt_pk_bf16(a[0], a[1]); o.y = cvt_pk_bf16(a[2], a[3]); o.z = cvt_pk_bf16(c[0], c[1]); o.w = cvt_pk_bf16(c[2], c[3]);
    *(uint4*)(P.pb + e) = o;
  }
}

DEVI void phase_ple(const Params& P, int layer, unsigned char* smem) {
  const int tid = tid_(), lane = tid & 63, w = tid >> 6, fh = lane >> 5;
  typedef _Float16 h2 __attribute__((ext_vector_type(2)));
  float* rowstat = (float*)(smem + 73728);
  const float* pp = P.p + (size_t)layer * T_ * 256;
  TileIter ti; tile_begin(ti, 8);
  for (int rt, ct; tile_next(ti, rt, ct);) {
    f32x4 ss;
    unsigned gp[4][8];
    {
      f32x16 gate[4]; zero_acc<4>(gate);
      gemm_mainloop_f32a<true>((const float*)P.z + (size_t)rt * 128 * 1024, 1024, P.wt_gate + (size_t)ct * 128 * 1024, 1024, 1024, gate, smem, ss);
#pragma unroll
      for (int i = 0; i < 4; ++i) { float v = ss[i]; v += shx<1>(v); v += shx<2>(v); v += shx<4>(v); if ((tid & 7) == 0) rowstat[(tid >> 3) + 32 * i] = rsqrtf(v * (1.f / 1024.f) + EPS_); }
      __syncthreads();
      float rsr[16];
#pragma unroll
      for (int r = 0; r < 16; ++r) rsr[r] = rowstat[32 * w + (r & 3) + 8 * (r >> 2) + 4 * fh];
#pragma unroll
      for (int n = 0; n < 4; ++n)
#pragma unroll
        for (int r = 0; r < 8; ++r) { h2 hv; hv[0] = (_Float16)sigmoidf_(gate[n][2 * r] * rsr[2 * r]); hv[1] = (_Float16)sigmoidf_(gate[n][2 * r + 1] * rsr[2 * r + 1]); gp[n][r] = __builtin_bit_cast(unsigned, hv); }
    }
    f32x16 acc[4]; zero_acc<4>(acc);
    gemm_mainloop_f32a<false>(pp + (size_t)rt * 128 * 256, 256, P.wt_pe + (size_t)ct * 128 * 256, 256, 256, acc, smem, ss);
#pragma unroll
    for (int n = 0; n < 4; ++n)
#pragma unroll
      for (int r = 0; r < 16; ++r) { const h2 gv = __builtin_bit_cast(h2, gp[n][r >> 1]); acc[n][r] *= (float)gv[r & 1]; }
    stage_f32(acc, (float*)smem);
    const size_t org = (size_t)(rt * 128) * 1024 + ct * 128;
    residual_out((const float*)smem, (const float*)P.z + org, P.out + org);
  }
}

__shared__ __attribute__((aligned(16))) unsigned char g_smem[SMEM_BYTES];
__shared__ Params g_P;
template <class Tp> DEVI Tp* uni(Tp* p) {
  const unsigned long long v = (unsigned long long)p;
  const unsigned lo = __builtin_amdgcn_readfirstlane((unsigned)v), hi = __builtin_amdgcn_readfirstlane((unsigned)(v >> 32));
  typedef __attribute__((address_space(1))) Tp* gptr_t;
  return (Tp*)(gptr_t)(((unsigned long long)hi << 32) | lo);
}
DEVI Params get_params() {
  Params P;
  P.x = uni(g_P.x);
  P.p = uni(g_P.p);
  P.pos = uni(g_P.pos);
  P.norm_g = uni(g_P.norm_g);
  P.ab_w_in = uni(g_P.ab_w_in);
  P.mla_q_norm = uni(g_P.mla_q_norm);
  P.mla_w_uq = uni(g_P.mla_w_uq);
  P.mla_kv_norm = uni(g_P.mla_kv_norm);
  P.mla_w_ukv = uni(g_P.mla_w_ukv);
  P.mla_q_gain = uni(g_P.mla_q_gain);
  P.mla_k_gain = uni(g_P.mla_k_gain);
  P.chk_q_gain = uni(g_P.chk_q_gain);
  P.chk_k_gain = uni(g_P.chk_k_gain);
  P.chk_rel_bias = uni(g_P.chk_rel_bias);
  P.ab_w_out = uni(g_P.ab_w_out);
  P.fox_w_in = uni(g_P.fox_w_in);
  P.fox_b_f = uni(g_P.fox_b_f);
  P.fox_q_gain = uni(g_P.fox_q_gain);
  P.fox_k_gain = uni(g_P.fox_k_gain);
  P.fox_w_out = uni(g_P.fox_w_out);
  P.pe_w = uni(g_P.pe_w);
  P.pe_gate_norm = uni(g_P.pe_gate_norm);
  P.pe_gate_w = uni(g_P.pe_gate_w);
  P.out = uni(g_P.out);
  P.wt_in = uni(g_P.wt_in);
  P.wt_uq = uni(g_P.wt_uq);
  P.wt_ukv = uni(g_P.wt_ukv);
  P.wt_out = uni(g_P.wt_out);
  P.wt_pe = uni(g_P.wt_pe);
  P.wt_gate = uni(g_P.wt_gate);
  P.cosT = uni(g_P.cosT);
  P.sinT = uni(g_P.sinT);
  P.uy = uni(g_P.uy);
  P.pb = uni(g_P.pb);
  P.z = uni(g_P.z);
  P.qm = uni(g_P.qm);
  P.km = uni(g_P.km);
  P.vtm = uni(g_P.vtm);
  P.vt = uni(g_P.vt);
  P.logf = uni(g_P.logf);
  P.cum = uni(g_P.cum);
  P.bar = uni(g_P.bar);
  return P;
}
#define NOINL DEVI
NOINL void ph_prep(int layer) { const Params P = get_params(); phase_prep(P, layer, g_smem); }
NOINL void ph_in_even(int l) { const Params P = get_params(); phase_in_even(P, l, g_smem); }
NOINL void ph_in_odd(int l) { const Params P = get_params(); phase_in_odd(P, l, g_smem); }
NOINL void ph_mla_up(int l) { const Params P = get_params(); phase_mla_up(P, l, g_smem); }
NOINL void ph_scan() { const Params P = get_params(); phase_scan(P, g_smem); }
NOINL void ph_attn_even(int l) { const Params P = get_params(); phase_attn_even(P, l, g_smem); }
NOINL void ph_attn_odd(int l) { const Params P = get_params(); phase_attn_odd(P, l, g_smem); }
NOINL void ph_outproj(int layer) { const Params P = get_params(); phase_outproj(P, layer, g_smem); }
NOINL void ph_norm2(int layer) { const Params P = get_params(); phase_norm2(P, layer); }
NOINL void ph_ple(int layer) { const Params P = get_params(); phase_ple(P, layer, g_smem); }

#define XB_TMO      128
#define XB_XCNT(j)  (256  + 64 * (j))
#define XB_XSUB(j)  (1280 + 64 * (j))
#define XB_XGEN(j)  (2304 + 64 * (j))
#define XB_TOP      3328
#define XB_TOPGEN   3392
#define XCD_BAR_WORDS 3456
#define XB_SPIN_CAP (1u << 18)
#define LAS __attribute__((address_space(3)))
DEVI unsigned xb_ld(unsigned* p) { return __hip_atomic_load(p, __ATOMIC_RELAXED, __HIP_MEMORY_SCOPE_AGENT); }
DEVI unsigned xb_add(unsigned* p, unsigned v) { return __hip_atomic_fetch_add(p, v, __ATOMIC_RELAXED, __HIP_MEMORY_SCOPE_AGENT); }
DEVI unsigned xb_xcc_id() { return (unsigned)__builtin_amdgcn_s_getreg((3 << 11) | 20) & 0xFu; }
#define XB_SPIN(cond, bar) do { unsigned _sp = 0; while (cond) { __builtin_amdgcn_s_sleep(1); \
    if ((++_sp & 255u) == 0u) { if (xb_ld(&(bar)[XB_TMO])) break; if (_sp > XB_SPIN_CAP) { atomicAdd(&(bar)[XB_TMO], 1u); break; } } } } while (0)
struct XcdBarrier { unsigned* bar; unsigned x; volatile LAS unsigned* st; };
DEVI void xcd_barrier_complete(unsigned* bar, unsigned x, unsigned& nloc, unsigned& nx);
DEVI XcdBarrier xcd_barrier_post(unsigned* bar, volatile LAS unsigned* st) {
  XcdBarrier b; b.bar = bar; b.x = xb_xcc_id(); b.st = st;
  if (tid_() == 0) {
    const unsigned lid = xb_add(&bar[XB_XCNT(b.x)], 1u);
    unsigned nloc, nx; xcd_barrier_complete(bar, b.x, nloc, nx);
    unsigned rank = 0;
    for (unsigned j = 0; j < 16; ++j) { if (j < b.x && xb_ld(&bar[XB_XCNT(j)]) > 0u) ++rank; }
    st[0] = nloc; st[1] = nx; st[2] = lid; st[3] = rank;
  }
  __syncthreads();
  return b;
}
DEVI void xcd_barrier_complete(unsigned* bar, unsigned x, unsigned& nloc, unsigned& nx) {
  const unsigned G = gridDim.x * gridDim.y * gridDim.z;
  unsigned sum, cnt, mine, sp = 0u;
  for (;;) {
    sum = 0u; cnt = 0u; mine = 0u;
#pragma unroll
    for (unsigned j = 0; j < 16; ++j) { const unsigned c = xb_ld(&bar[XB_XCNT(j)]); sum += c; cnt += (c > 0u) ? 1u : 0u; mine = (j == x) ? c : mine; }
    if (sum == G) break;
    __builtin_amdgcn_s_sleep(1);
    if ((++sp & 255u) == 0u) { if (xb_ld(&bar[XB_TMO])) break; if (sp > XB_SPIN_CAP) { atomicAdd(&bar[XB_TMO], 1u); break; } }
  }
  nloc = mine > 0u ? mine : 1u; nx = cnt > 0u ? cnt : 1u;
}
DEVI void xcd_barrier(const XcdBarrier& b) {
  asm volatile("s_waitcnt vmcnt(0)" ::: "memory");
  __syncthreads();
  if (tid_() == 0) {
    unsigned* bar = b.bar;
    __builtin_amdgcn_s_waitcnt(0);
    unsigned nloc = b.st[0], nx = b.st[1];
    if (nloc == 0u) { xcd_barrier_complete(bar, b.x, nloc, nx); b.st[0] = nloc; b.st[1] = nx; }
    const unsigned old = xb_add(&bar[XB_XSUB(b.x)], 1u);
    const unsigned gen = old / nloc;
    if (old + 1u == (gen + 1u) * nloc) {
      __builtin_amdgcn_fence(__ATOMIC_RELEASE, "agent");
      asm volatile("s_waitcnt vmcnt(0)" ::: "memory");
      const unsigned og = xb_add(&bar[XB_TOP], 1u);
      const unsigned tg = og / nx;
      if (og + 1u == (tg + 1u) * nx) xb_add(&bar[XB_TOPGEN], 1u);
      else XB_SPIN(xb_ld(&bar[XB_TOPGEN]) == tg, bar);
      __builtin_amdgcn_fence(__ATOMIC_ACQUIRE, "agent");
      xb_add(&bar[XB_XGEN(b.x)], 1u);
      asm volatile("s_waitcnt vmcnt(0)" ::: "memory");
    } else {
      XB_SPIN(xb_ld(&bar[XB_XGEN(b.x)]) == gen, bar);
      __builtin_amdgcn_fence(__ATOMIC_ACQUIRE, "agent");
      asm volatile("s_waitcnt vmcnt(0)" ::: "memory");
    }
  }
  __syncthreads();
}

template <bool COOP>
__global__ void __launch_bounds__(256, 2) mega(Params Pk, int ph_begin, int ph_end) {
  if (tid_() == 0) g_P = Pk;
  if (tid_() == 0) g_xb = make_uint4(0u, 0u, 0u, 0u);
  if (COOP && blockIdx.x == 0) { for (int i = tid_(); i < XCD_BAR_WORDS; i += 256) __hip_atomic_store(Pk.bar + i, 0u, __ATOMIC_RELAXED, __HIP_MEMORY_SCOPE_AGENT); }
  __syncthreads();
  XcdBarrier xb; xb.bar = Pk.bar; xb.x = 0; xb.st = (volatile LAS unsigned*)&g_xb;
  if (COOP) { cg::this_grid().sync(); xb = xcd_barrier_post(Pk.bar, (volatile LAS unsigned*)&g_xb); }
  for (int ph = ph_begin; ph < ph_end; ++ph) {
    const int layer = ph / 6, j = ph % 6, l = layer >> 1;
    const bool even = (layer & 1) == 0;
#ifdef PROBE_MASK
    for (int rep_ = 0; rep_ < ((((PROBE_MASK) >> j) & 1) ? 2 : 1); ++rep_)
#endif
    switch (j) {
      case 0: ph_prep(layer); break;
      case 1: if (even) ph_in_even(l); else ph_in_odd(l); break;
      case 2: if (even) ph_mla_up(l); else ph_scan(); break;
      case 3: if (even) ph_attn_even(l); else ph_attn_odd(l); break;
      case 4: ph_outproj(layer); break;
      default: ph_ple(layer); break;
    }
    if (COOP && ph + 1 < ph_end) {
      xcd_barrier(xb);
    }
  }
}

extern "C" void kernel_launch(void* const* d_in, const int* in_sizes, int n_in, void* d_out, int out_size, void* d_ws, size_t ws_size, hipStream_t stream) {
  Params P{};
  P.x = (const float*)d_in[0]; P.p = (const float*)d_in[1]; P.pos = (const int*)d_in[2];
  P.norm_g = (const float*)d_in[3]; P.ab_w_in = (const float*)d_in[4]; P.mla_q_norm = (const float*)d_in[5]; P.mla_w_uq = (const float*)d_in[6];
  P.mla_kv_norm = (const float*)d_in[7]; P.mla_w_ukv = (const float*)d_in[8]; P.mla_q_gain = (const float*)d_in[9]; P.mla_k_gain = (const float*)d_in[10];
  P.chk_q_gain = (const float*)d_in[11]; P.chk_k_gain = (const float*)d_in[12]; P.chk_rel_bias = (const float*)d_in[13]; P.ab_w_out = (const float*)d_in[14];
  P.fox_w_in = (const float*)d_in[15]; P.fox_b_f = (const float*)d_in[16]; P.fox_q_gain = (const float*)d_in[17]; P.fox_k_gain = (const float*)d_in[18];
  P.fox_w_out = (const float*)d_in[19]; P.pe_w = (const float*)d_in[20]; P.pe_gate_norm = (const float*)d_in[21]; P.pe_gate_w = (const float*)d_in[22];
  P.out = (float*)d_out;
  unsigned char* wsp = (unsigned char*)d_ws; size_t off = 0;
  auto take = [&](size_t bytes) { unsigned char* r = wsp + off; off += (bytes + 255) & ~(size_t)255; return r; };
  P.wt_in = (bf16_t*)take((size_t)4224 * 1024 * 2); P.wt_uq = (bf16_t*)take((size_t)768 * 384 * 2); P.wt_ukv = (bf16_t*)take((size_t)1024 * 256 * 2);
  P.wt_out = (bf16_t*)take((size_t)1024 * 1024 * 2); P.wt_pe = (bf16_t*)take((size_t)1024 * 256 * 2); P.wt_gate = (bf16_t*)take((size_t)1024 * 1024 * 2);
  P.cosT = (float*)take((size_t)T_ * 16 * 4); P.sinT = (float*)take((size_t)T_ * 16 * 4);
  P.uy = (bf16_t*)take((size_t)T_ * 1024 * 2); P.pb = (bf16_t*)take((size_t)T_ * 256 * 2);
  P.z = (bf16_t*)take((size_t)T_ * ZO * 2);
  P.qm = (bf16_t*)take((size_t)T_ * 8 * 96 * 2); P.km = (bf16_t*)take((size_t)T_ * 8 * 96 * 2); P.vtm = (bf16_t*)take((size_t)T_ * 8 * 64 * 2);
  P.vt = (bf16_t*)take((size_t)T_ * 16 * 64 * 2);
  P.logf = (float*)take((size_t)T_ * 16 * 4); P.cum = (float*)take((size_t)T_ * 16 * 4);
  P.bar = (unsigned*)take((size_t)XCD_BAR_WORDS * 4);
  if (off > ws_size) { fprintf(stderr, "workspace too small: need %zu have %zu\n", off, ws_size); }
#if USE_COOP
  static int grid_blocks = 0;
  if (!grid_blocks) {
    int dev = 0, cus = 0, per_cu = 0;
    hipGetDevice(&dev);
    hipDeviceGetAttribute(&cus, hipDeviceAttributeMultiprocessorCount, dev);
    hipOccupancyMaxActiveBlocksPerMultiprocessor(&per_cu, mega<true>, 256, 0);
    if (per_cu > 2) per_cu = 2;
    if (per_cu < 1) per_cu = 1;
    grid_blocks = cus * per_cu;
  }
  int pb = 0, pe = NPH;
  void* args[] = {&P, &pb, &pe};
  hipError_t e = hipLaunchCooperativeKernel((void*)mega<true>, dim3(grid_blocks), dim3(256), args, 0, stream);
  if (e != hipSuccess) fprintf(stderr, "cooperative launch failed: %s (grid %d)\n", hipGetErrorString(e), grid_blocks);
#else
  for (int ph = 0; ph < NPH; ++ph) mega<false><<<512, 256, 0, stream>>>(P, ph, ph + 1);
#endif
}
```
